# Optimizing an MI355X kernel written in HIP

```python
import jax, jax.numpy as jnp
from jax import lax
import numpy as np

D_MODEL = 2048
BATCH = 16
SEQ = 2048
DEPTH = 1

RET_HEADS = 8
RET_DK = 128
RET_DV = 256
RET_CHUNK = 128
ROPE_BASE = 10000.0
SWA_Q_HEADS = 16
SWA_KV_HEADS = 4
SWA_HEAD_DIM = 64
SWA_WINDOW = 128
SWA_BLOCK = 128
D_FF = 5632
CONV_WIDTH = 3
RMS_EPS = 1e-6

RET_QK_W = RET_HEADS * RET_DK
RET_V_W = RET_HEADS * RET_DV
SWA_Q_W = SWA_Q_HEADS * SWA_HEAD_DIM
SWA_KV_W = SWA_KV_HEADS * SWA_HEAD_DIM
IN_WIDTHS = (RET_QK_W, RET_QK_W, RET_V_W, RET_V_W, SWA_Q_W, SWA_KV_W, SWA_KV_W, D_MODEL, D_MODEL)
IN_WIDTH = sum(IN_WIDTHS)
IN_SPLITS = tuple(int(s) for s in np.cumsum(IN_WIDTHS)[:-1])

kernel_name = "hybrid_retention_swa_sink_convffn"


def rmsnorm(x, g):
    xf = x.astype(jnp.float32)
    y = xf * lax.rsqrt(jnp.mean(xf * xf, axis=-1, keepdims=True) + RMS_EPS)
    return (y * g.astype(jnp.float32)).astype(x.dtype)


def rotary(x, pos):
    d = x.shape[-1]
    inv = 1.0 / (ROPE_BASE ** (jnp.arange(0, d, 2, dtype=jnp.float32) / d))
    ang = pos.astype(jnp.float32)[:, None] * inv[None, :]
    cos = jnp.cos(ang)[None, :, None, :]
    sin = jnp.sin(ang)[None, :, None, :]
    x1, x2 = x[..., : d // 2], x[..., d // 2:]
    return jnp.concatenate([x1 * cos - x2 * sin, x1 * sin + x2 * cos], axis=-1)


def retention_chunkwise(q, k, v):
    B, S, H, dk = q.shape
    dv = v.shape[-1]
    C = RET_CHUNK
    N = S // C
    log_gamma = jnp.log(1.0 - 2.0 ** (-5.0 - jnp.arange(H, dtype=jnp.float32)))
    idx = jnp.arange(C, dtype=jnp.float32)
    rel = idx[:, None] - idx[None, :]
    inner_decay = jnp.where(rel[None] >= 0,
                            jnp.exp(log_gamma[:, None, None] * jnp.maximum(rel, 0.0)[None]), 0.0)
    xi = jnp.exp(log_gamma[:, None] * (idx + 1.0))[None, :, :, None]
    zeta = jnp.exp(log_gamma[:, None] * (C - 1.0 - idx))[None, :, :, None]
    chunk_decay = jnp.exp(log_gamma * C)[None, :, None, None]
    k = k * (dk ** -0.5)

    def to_chunks(t):
        return t.reshape(B, N, C, H, t.shape[-1]).transpose(1, 0, 3, 2, 4)

    def step(state, inp):
        qi, ki, vi = inp
        scores = jnp.einsum('bhqd,bhkd->bhqk', qi, ki) * inner_decay[None]
        inner = jnp.einsum('bhqk,bhkv->bhqv', scores, vi)
        cross = jnp.einsum('bhqd,bhdv->bhqv', qi, state) * xi
        new_state = state * chunk_decay + jnp.einsum('bhkd,bhkv->bhdv', ki * zeta, vi)
        return new_state, inner + cross

    init = jnp.zeros((B, H, dk, dv), jnp.float32)
    _, out = lax.scan(step, init, (to_chunks(q), to_chunks(k), to_chunks(v)))
    return out.transpose(1, 0, 3, 2, 4).reshape(B, S, H, dv)


def swa_attention_sinks(q, k, v, sinks):
    B, S, Hq, dh = q.shape
    Hkv = k.shape[2]
    G = Hq // Hkv
    C = SWA_BLOCK
    N = S // C
    qb = q.astype(jnp.float32).reshape(B, N, C, Hkv, G, dh)

    def with_prev(t):
        tb = t.astype(jnp.float32).reshape(B, N, C, Hkv, dh)
        prev = jnp.pad(tb[:, :-1], ((0, 0), (1, 0), (0, 0), (0, 0), (0, 0)))
        return jnp.concatenate([prev, tb], axis=2)

    kw = with_prev(k)
    vw = with_prev(v)
    scores = jnp.einsum('bnqhgd,bnkhd->bnhgqk', qb, kw) * (dh ** -0.5)
    qpos = jnp.arange(C)[:, None] + C
    kpos = jnp.arange(2 * C)[None, :]
    relp = qpos - kpos
    band = (relp >= 0) & (relp < SWA_WINDOW)
    blk = jnp.arange(N)
    valid = band[None] & ((blk[:, None, None] > 0) | (kpos[None] >= C))
    scores = jnp.where(valid[None, :, None, None], scores, -jnp.inf)
    sink = sinks.astype(jnp.float32).reshape(Hkv, G)[None, None, :, :, None, None]
    m = jnp.maximum(jnp.max(scores, axis=-1, keepdims=True), sink)
    e = jnp.exp(scores - m)
    p = e / (jnp.sum(e, axis=-1, keepdims=True) + jnp.exp(sink - m))
    out = jnp.einsum('bnhgqk,bnkhd->bnqhgd', p, vw)
    return out.reshape(B, S, Hq * dh)


def causal_depthwise_conv(u, w, b):
    S = u.shape[1]
    up = jnp.pad(u, ((0, 0), (CONV_WIDTH - 1, 0), (0, 0)))
    y = b
    for kk in range(CONV_WIDTH):
        y = y + up[:, kk:kk + S] * w[kk]
    return y


def setup_inputs(seed: int = 0) -> dict:
    key = jax.random.key(seed)
    ks = jax.random.split(key, 16)
    f = jnp.float32
    L = DEPTH

    def nrm(k, shape, scale):
        return jax.random.normal(k, shape, f) * scale

    return {
        "x": jax.random.normal(ks[0], (BATCH, SEQ, D_MODEL), f),
        "g_pre_mix": 1.0 + nrm(ks[1], (L, D_MODEL), 0.02),
        "w_in": nrm(ks[2], (L, D_MODEL, IN_WIDTH), D_MODEL ** -0.5),
        "w_ret_o": nrm(ks[3], (L, RET_V_W, D_MODEL), RET_V_W ** -0.5),
        "w_swa_o": nrm(ks[4], (L, SWA_Q_W, D_MODEL), SWA_Q_W ** -0.5),
        "w_out": nrm(ks[5], (L, D_MODEL, D_MODEL), D_MODEL ** -0.5),
        "swa_sinks": nrm(ks[6], (L, SWA_Q_HEADS), 0.5),
        "g_post_mix": 1.0 + nrm(ks[7], (L, D_MODEL), 0.02),
        "g_pre_ffn": 1.0 + nrm(ks[8], (L, D_MODEL), 0.02),
        "w_up": nrm(ks[9], (L, D_MODEL, 2 * D_FF), D_MODEL ** -0.5),
        "conv_w": nrm(ks[10], (L, CONV_WIDTH, 2 * D_FF), CONV_WIDTH ** -0.5),
        "conv_b": nrm(ks[11], (L, 2 * D_FF), 0.01),
        "w_down": nrm(ks[12], (L, D_FF, D_MODEL), D_FF ** -0.5),
        "g_post_ffn": 1.0 + nrm(ks[13], (L, D_MODEL), 0.02),
    }


def reference(x, g_pre_mix, w_in, w_ret_o, w_swa_o, w_out, swa_sinks, g_post_mix,
              g_pre_ffn, w_up, conv_w, conv_b, w_down, g_post_ffn):
    B, S, _ = x.shape
    pos = jnp.arange(S, dtype=jnp.int32)
    for l in range(DEPTH):
        h = rmsnorm(x, g_pre_mix[l])
        proj = h @ w_in[l]
        rq, rk, rv, rg, sq, sk, sv, gr, gs = jnp.split(proj, IN_SPLITS, axis=-1)

        rq = rotary(rq.astype(jnp.float32).reshape(B, S, RET_HEADS, RET_DK), pos)
        rk = rotary(rk.astype(jnp.float32).reshape(B, S, RET_HEADS, RET_DK), pos)
        rv = rv.astype(jnp.float32).reshape(B, S, RET_HEADS, RET_DV)
        ret = retention_chunkwise(rq, rk, rv)
        ret = ret * lax.rsqrt(jnp.mean(ret * ret, axis=-1, keepdims=True) + RMS_EPS)
        ret = (jax.nn.silu(rg.astype(jnp.float32)) * ret.reshape(B, S, RET_V_W)).astype(x.dtype)
        ret_out = ret @ w_ret_o[l]

        swa = swa_attention_sinks(sq.reshape(B, S, SWA_Q_HEADS, SWA_HEAD_DIM),
                                  sk.reshape(B, S, SWA_KV_HEADS, SWA_HEAD_DIM),
                                  sv.reshape(B, S, SWA_KV_HEADS, SWA_HEAD_DIM),
                                  swa_sinks[l]).astype(x.dtype)
        swa_out = swa @ w_swa_o[l]

        mixed = jax.nn.sigmoid(gr) * ret_out + jax.nn.sigmoid(gs) * swa_out
        x = x + rmsnorm(mixed @ w_out[l], g_post_mix[l])

        h = rmsnorm(x, g_pre_ffn[l])
        u = causal_depthwise_conv(h @ w_up[l], conv_w[l], conv_b[l])
        val, gate = jnp.split(u, 2, axis=-1)
        y = (jax.nn.gelu(gate, approximate=True) * val) @ w_down[l]
        x = x + rmsnorm(y, g_post_ffn[l])
    return x
```

```cpp
#include <hip/hip_runtime.h>
#include <hip/hip_cooperative_groups.h>
#include <cstdio>
#include <cstdint>
namespace cg = cooperative_groups;

__device__ __forceinline__ int lane_id_asm() { int l; asm volatile("v_mbcnt_lo_u32_b32 %0, -1, 0\n\tv_mbcnt_hi_u32_b32 %0, -1, %0" : "=v"(l)); return l; }
namespace pg8 {
#define PG8_LAS __attribute__((address_space(3)))
typedef unsigned short bf16_t;
typedef short bf16x8 __attribute__((ext_vector_type(8)));
typedef float f32x4 __attribute__((ext_vector_type(4)));
typedef float f32x2 __attribute__((ext_vector_type(2)));
typedef unsigned u32x4 __attribute__((ext_vector_type(4)));
typedef unsigned u32x2 __attribute__((ext_vector_type(2)));
constexpr int BM = 256, BK = 64, HALF = 128, HTB = HALF * BK * 2  , STAGE_BYTES = 8 * HTB, NXCD = 8, WGM = 8;

__host__ __device__ __forceinline__ int lds_byte(int r, int c) { const int st = (r >> 4) * 2 + (c >> 5), rr = r & 15, cc = c & 31, ob = rr * 64 + cc * 2; return st * 1024 + (ob ^ (((ob >> 9) & 1) << 5)); }
__host__ __device__ __forceinline__ void stage_rc(int b, int& R, int& C) { const int st = b / 1024, sb = b % 1024, swz = sb ^ (((sb >> 9) & 1) << 5); R = (st >> 1) * 16 + swz / 64; C = (st & 1) * 32 + (swz % 64) / 2; }
__host__ __device__ __forceinline__ int perm32(int rho) { const int n = rho >> 4, i = rho & 15; return 8 * (i >> 2) + 4 * n + (i & 3); }

struct Unit { int pm, pn; };
struct Gemm { const bf16_t* A; const bf16_t* Bt; int M, N, K, lda; size_t apst; };

struct StaticOrder {
    int nM, nN, nwg, G, c;
    __host__ __device__ void init(int M, int N, int G_, int c_) { nM = M / BM; nN = N / BM; nwg = nM * nN; G = G_; c = c_; }
    __host__ __device__ bool next(int i, Unit& u) const {
        const long L = (long)i * G + c; if (L >= nwg) return false;
        int wgid = (int)L; { const int q = nwg / NXCD, r = nwg % NXCD, xcd = wgid % NXCD, off = wgid / NXCD; wgid = (xcd < r ? xcd * (q + 1) : r * (q + 1) + (xcd - r) * q) + off; }
        const int nig = WGM * nN, gid = wgid / nig, fm = gid * WGM, gsz = (nM - fm) < WGM ? (nM - fm) : WGM;
        u.pm = fm + ((wgid % nig) % gsz); u.pn = (wgid % nig) / gsz; return true;
    }
    __device__ __forceinline__ void a_ready(const Unit&) const {}
    __device__ __forceinline__ void done(const Unit&) const {}
};

__device__ __forceinline__ unsigned cvt_pk_bf16(float lo, float hi) { unsigned r; asm volatile("v_cvt_pk_bf16_f32 %0, %1, %2" : "=v"(r) : "v"(lo), "v"(hi)); return r; }
__device__ __forceinline__ float bf_lo(unsigned w) { return __uint_as_float(w << 16); }
__device__ __forceinline__ float bf_hi(unsigned w) { return __uint_as_float(w & 0xffff0000u); }
__device__ __forceinline__ float gclamp(float x) { return fminf(fmaxf(x, -30.f), 30.f); }
__device__ __forceinline__ float sigmoidf_(float x) { return __builtin_amdgcn_rcpf(1.0f + __expf(-x)); }

template <bool HALO> struct EpiBf16 {
    static constexpr bool PERM = true, AFTER_DRAIN = false;
    bf16_t* O; int ldc; size_t pst; bf16_t* halo; int ldh; int silu_lo, silu_hi;
    __device__ __forceinline__ void operator()(const f32x4 (&acc)[2][2][4][2], const Unit& u, int wr, int wc, int fr, int fq) const {
        const int row0 = u.pm * BM + wr * 64 + fr; const int colt = wc * 32 + 8 * fq; const int col0 = u.pn * BM + colt;
#pragma unroll
        for (int ai = 0; ai < 2; ++ai)
#pragma unroll
            for (int m = 0; m < 4; ++m) { bf16_t* rowp = O + (size_t)u.pn * pst + (size_t)(row0 + ai * HALF + m * 16) * ldc + colt;
#pragma unroll
                for (int bj = 0; bj < 2; ++bj) { f32x4 v0 = acc[ai][bj][m][0], v1 = acc[ai][bj][m][1];
                    if (u.pn >= silu_lo && u.pn < silu_hi) {
#pragma unroll
                        for (int k = 0; k < 4; ++k) { v0[k] *= sigmoidf_(v0[k]); v1[k] *= sigmoidf_(v1[k]); } }
                    u32x4 w; w.x = cvt_pk_bf16(v0[0], v0[1]); w.y = cvt_pk_bf16(v0[2], v0[3]); w.z = cvt_pk_bf16(v1[0], v1[1]); w.w = cvt_pk_bf16(v1[2], v1[3]);
                    *(u32x4*)(rowp + bj * HALF) = w;
                    if (HALO) { if (m == 3 && wr == 1 && fr >= 14) *(u32x4*)(halo + (size_t)((u.pm * 2 + ai) * 2 + (fr - 14)) * ldh + col0 + bj * HALF) = w; } } }
    }
};
__device__ __forceinline__ float dpp_ror1(float x) { return __int_as_float(__builtin_amdgcn_mov_dpp(__float_as_int(x), 0x121, 0xf, 0xf, true)); }
__device__ __forceinline__ float dpp_ror2(float x) { return __int_as_float(__builtin_amdgcn_mov_dpp(__float_as_int(x), 0x122, 0xf, 0xf, true)); }
__device__ __forceinline__ float dpp_shr1(float old, float x) { return __int_as_float(__builtin_amdgcn_update_dpp(__float_as_int(old), __float_as_int(x), 0x111, 0xf, 0xf, false)); }
__device__ __forceinline__ float dpp_shr2(float old, float x) { return __int_as_float(__builtin_amdgcn_update_dpp(__float_as_int(old), __float_as_int(x), 0x112, 0xf, 0xf, false)); }
__device__ __forceinline__ float conv3(float b, float w0, float p2, float w1, float p1, float w2, float u) {
    float r; asm("v_fma_f32 %0, %1, %2, %3" : "=v"(r) : "v"(w0), "v"(p2), "v"(b)); asm("v_fmac_f32 %0, %1, %2" : "+v"(r) : "v"(w1), "v"(p1)); asm("v_fmac_f32 %0, %1, %2" : "+v"(r) : "v"(w2), "v"(u)); return r; }
__device__ __forceinline__ float gelu_tanh_f(float x) { const float z = x * (0.7978845608028654f + 0.035677408136300125f * x * x); return x * __builtin_amdgcn_rcpf(1.0f + __builtin_amdgcn_exp2f(-2.8853900817779268f * z)); }
struct EpiConv {
    static constexpr bool PERM = true, AFTER_DRAIN = false;
    bf16_t* Gp; size_t pst; const float* cw; const float* cb; bf16_t* edge; int ff;
    __device__ __forceinline__ void operator()(const f32x4 (&acc)[2][2][4][2], const Unit& u, int wr, int wc, int fr, int fq) const {
        const int ct = wc * 32 + 8 * fq;
        const int C = u.pn * 128 + ct;
#pragma unroll
        for (int ai = 0; ai < 2; ++ai) { const int Gi = u.pm * 4 + ai * 2 + wr;
#pragma unroll
            for (int which = 0; which < 2; ++which) { const int m = which ? 3 : 0; const bool on = which ? (fr >= 14) : (fr < 2); const int slot = which ? fr - 12 : fr;
                if (on) {
#pragma unroll
                    for (int bj = 0; bj < 2; ++bj) { const f32x4 v0 = acc[ai][bj][m][0], v1 = acc[ai][bj][m][1];
                        u32x4 w; w.x = cvt_pk_bf16(v0[0], v0[1]); w.y = cvt_pk_bf16(v0[2], v0[3]); w.z = cvt_pk_bf16(v1[0], v1[1]); w.w = cvt_pk_bf16(v1[2], v1[3]);
                        *(u32x4*)(edge + ((size_t)(Gi * 4 + slot) * 44 + u.pn) * 256 + bj * 128 + ct) = w; } } } }
        float c[2][2][4][8];
#pragma unroll
        for (int ai = 0; ai < 2; ++ai)
#pragma unroll
            for (int bj = 0; bj < 2; ++bj)
#pragma unroll
                for (int m = 0; m < 4; ++m)
#pragma unroll
                    for (int e = 0; e < 8; ++e) c[ai][bj][m][e] = acc[ai][bj][m][e >> 2][e & 3];
#pragma unroll
        for (int bj = 0; bj < 2; ++bj) { const int Cg = C + bj * ff;
            const f32x4 w0a = *(const f32x4*)(cw + Cg), w0b = *(const f32x4*)(cw + Cg + 4), w1a = *(const f32x4*)(cw + 2 * ff + Cg), w1b = *(const f32x4*)(cw + 2 * ff + Cg + 4);
            const f32x4 w2a = *(const f32x4*)(cw + 4 * ff + Cg), w2b = *(const f32x4*)(cw + 4 * ff + Cg + 4), ba = *(const f32x4*)(cb + Cg), bb = *(const f32x4*)(cb + Cg + 4);
#pragma unroll
            for (int e = 0; e < 8; ++e) { const float w0 = (e >> 2) ? w0b[e & 3] : w0a[e & 3], w1 = (e >> 2) ? w1b[e & 3] : w1a[e & 3], w2 = (e >> 2) ? w2b[e & 3] : w2a[e & 3], bs = (e >> 2) ? bb[e & 3] : ba[e & 3];
#pragma unroll
                for (int ai = 0; ai < 2; ++ai) {
                    const float u0 = c[ai][bj][0][e], u1 = c[ai][bj][1][e], u2 = c[ai][bj][2][e], u3 = c[ai][bj][3][e];
                    const float p13 = dpp_shr1(dpp_ror1(u2), u3), p12 = dpp_shr1(dpp_ror1(u1), u2), p11 = dpp_shr1(dpp_ror1(u0), u1), p10 = dpp_shr1(0.f, u0);
                    const float p23 = dpp_shr2(dpp_ror2(u2), u3), p22 = dpp_shr2(dpp_ror2(u1), u2), p21 = dpp_shr2(dpp_ror2(u0), u1), p20 = dpp_shr2(0.f, u0);
                    c[ai][bj][3][e] = conv3(bs, w0, p23, w1, p13, w2, u3);
                    c[ai][bj][2][e] = conv3(bs, w0, p22, w1, p12, w2, u2);
                    c[ai][bj][1][e] = conv3(bs, w0, p21, w1, p11, w2, u1);
                    c[ai][bj][0][e] = conv3(bs, w0, p20, w1, p10, w2, u0); } } }
        const int row0 = u.pm * BM + wr * 64 + fr;
#pragma unroll
        for (int ai = 0; ai < 2; ++ai)
#pragma unroll
            for (int m = 0; m < 4; ++m) { float o[8];
#pragma unroll
                for (int e = 0; e < 8; e += 2) { const f32x2 x = {c[ai][1][m][e], c[ai][1][m][e + 1]}, vv = {c[ai][0][m][e], c[ai][0][m][e + 1]};
                    const f32x2 arg = x * ((x * x) * (-0.10294323f) + (-2.30220819f)); f32x2 d; d.x = 1.0f + __builtin_amdgcn_exp2f(arg.x); d.y = 1.0f + __builtin_amdgcn_exp2f(arg.y);
                    f32x2 r; r.x = __builtin_amdgcn_rcpf(d.x); r.y = __builtin_amdgcn_rcpf(d.y); const f32x2 oo = (x * vv) * r; o[e] = oo.x; o[e + 1] = oo.y; }
                u32x4 w; w.x = cvt_pk_bf16(o[0], o[1]); w.y = cvt_pk_bf16(o[2], o[3]); w.z = cvt_pk_bf16(o[4], o[5]); w.w = cvt_pk_bf16(o[6], o[7]);
                if (m > 0 || fr >= 2) *(u32x4*)(Gp + (size_t)(u.pn >> 1) * pst + (size_t)(row0 + ai * HALF + m * 16) * 256 + (u.pn & 1) * 128 + ct) = w; }
    }
};

struct MidNone { static constexpr bool ON = false; int t_at; __device__ __forceinline__ void operator()(f32x4 (&)[2][2][4][2], const Unit&, int, int, int, int) const {} };
struct MidGate { static constexpr bool ON = true; int t_at; const bf16_t* Gr; const bf16_t* Gs; size_t pst;
    __device__ __forceinline__ void operator()(f32x4 (&acc)[2][2][4][2], const Unit& u, int wr, int wc, int fr_, int fq_) const {
        const int l = lane_id_asm(), fr = l & 15, fq = l >> 4;
        const int row0 = u.pm * BM + wr * 64 + fr; const int col0 = wc * 32 + 8 * fq; const size_t pb = (size_t)u.pn * pst;
#pragma unroll
        for (int ai = 0; ai < 2; ++ai)
#pragma unroll
            for (int m = 0; m < 4; ++m) { const size_t off = pb + (size_t)(row0 + ai * HALF + m * 16) * 256 + col0;
#pragma unroll
                for (int bj = 0; bj < 2; ++bj) { const u32x4 a = *(const u32x4*)(Gr + off + bj * HALF), b = *(const u32x4*)(Gs + off + bj * HALF);
                    f32x4 r0, r1;
                    r0[0] = (1.f + __expf(-gclamp(bf_lo(b.x)))) * __builtin_amdgcn_rcpf(1.f + __expf(-gclamp(bf_lo(a.x)))); r0[1] = (1.f + __expf(-gclamp(bf_hi(b.x)))) * __builtin_amdgcn_rcpf(1.f + __expf(-gclamp(bf_hi(a.x))));
                    r0[2] = (1.f + __expf(-gclamp(bf_lo(b.y)))) * __builtin_amdgcn_rcpf(1.f + __expf(-gclamp(bf_lo(a.y)))); r0[3] = (1.f + __expf(-gclamp(bf_hi(b.y)))) * __builtin_amdgcn_rcpf(1.f + __expf(-gclamp(bf_hi(a.y))));
                    r1[0] = (1.f + __expf(-gclamp(bf_lo(b.z)))) * __builtin_amdgcn_rcpf(1.f + __expf(-gclamp(bf_lo(a.z)))); r1[1] = (1.f + __expf(-gclamp(bf_hi(b.z)))) * __builtin_amdgcn_rcpf(1.f + __expf(-gclamp(bf_hi(a.z))));
                    r1[2] = (1.f + __expf(-gclamp(bf_lo(b.w)))) * __builtin_amdgcn_rcpf(1.f + __expf(-gclamp(bf_lo(a.w)))); r1[3] = (1.f + __expf(-gclamp(bf_hi(b.w)))) * __builtin_amdgcn_rcpf(1.f + __expf(-gclamp(bf_hi(a.w))));
                    acc[ai][bj][m][0] *= r0; acc[ai][bj][m][1] *= r1; } }
    }
};
struct EpiGateOut {
    static constexpr bool PERM = true, AFTER_DRAIN = false;
    const bf16_t* G; bf16_t* O; size_t pst;
    __device__ __forceinline__ void operator()(const f32x4 (&acc)[2][2][4][2], const Unit& u, int wr, int wc, int fr, int fq) const {
        const int row0 = u.pm * BM + wr * 64 + fr; const int col0 = wc * 32 + 8 * fq; const size_t pb = (size_t)u.pn * pst;
#pragma unroll
        for (int ai = 0; ai < 2; ++ai)
#pragma unroll
            for (int m = 0; m < 4; ++m) { const size_t off = pb + (size_t)(row0 + ai * HALF + m * 16) * 256 + col0;
#pragma unroll
                for (int bj = 0; bj < 2; ++bj) { const u32x4 gw = *(const u32x4*)(G + off + bj * HALF);
                    f32x4 v0 = acc[ai][bj][m][0], v1 = acc[ai][bj][m][1];
                    v0[0] *= sigmoidf_(gclamp(bf_lo(gw.x))); v0[1] *= sigmoidf_(gclamp(bf_hi(gw.x))); v0[2] *= sigmoidf_(gclamp(bf_lo(gw.y))); v0[3] *= sigmoidf_(gclamp(bf_hi(gw.y)));
                    v1[0] *= sigmoidf_(gclamp(bf_lo(gw.z))); v1[1] *= sigmoidf_(gclamp(bf_hi(gw.z))); v1[2] *= sigmoidf_(gclamp(bf_lo(gw.w))); v1[3] *= sigmoidf_(gclamp(bf_hi(gw.w)));
                    u32x4 w; w.x = cvt_pk_bf16(v0[0], v0[1]); w.y = cvt_pk_bf16(v0[2], v0[3]); w.z = cvt_pk_bf16(v1[0], v1[1]); w.w = cvt_pk_bf16(v1[2], v1[3]);
                    *(u32x4*)(O + off + bj * HALF) = w; } }
    }
};

template <class Epi, class Sched, bool ALIGN_EPI = false, bool SP2 = false, class Mid = MidNone>
__device__ __forceinline__ void gemm_phase(PG8_LAS unsigned char* lds, const Gemm g, const Sched& S, const Epi& E, const int swave, const Mid mid = Mid{}) {
    const int lane = lane_id_asm(), wid = swave, tid = wid * 64 + lane, wr = wid >> 2, wc = wid & 3, fr = lane & 15, fq = lane >> 4;
    const int K = g.K, nt = K / BK;
    unsigned voffA[2], voffB[2];
#pragma unroll
    for (int i = 0; i < 2; ++i) { int R, C; stage_rc(tid * 16 + i * 8192, R, C); const int Rb = Epi::PERM ? ((R & ~31) + perm32(R & 31)) : R;
        voffA[i] = (unsigned)(R * g.lda + C) * 2u; voffB[i] = (unsigned)(Rb * K + C) * 2u; }
    const size_t kstep = (size_t)(BK * 2);
    const size_t hstepA = (size_t)HALF * g.lda * 2, hstepB = (size_t)HALF * K * 2;
    const size_t tstepA = 2 * hstepA, tstepB = 2 * hstepB;
    const unsigned ldsw = (unsigned)wid * 1024u;
    const int aoff = lds_byte(wr * 64 + fr, fq * 8), boff = lds_byte(wc * 32 + fr, fq * 8);
#define PG8_SA(b, h) (((b) * 2 + (h)) * HTB)
#define PG8_SB(b, h) ((4 + (b) * 2 + (h)) * HTB)
#define PG8_STAGE(bufoff, gbase, voff) do { _Pragma("unroll") for (int _i = 0; _i < 2; ++_i) \
        __builtin_amdgcn_global_load_lds((const unsigned*)((const char*)(gbase) + (voff)[_i]), (PG8_LAS unsigned*)(lds + (bufoff) + ldsw + _i * 8192), 16, 0, 0); } while (0)
#define PG8_LDA(dst, b, h) do { _Pragma("unroll") for (int m = 0; m < 4; ++m) _Pragma("unroll") for (int k = 0; k < 2; ++k) dst[m][k] = *(const PG8_LAS bf16x8*)(lds + PG8_SA(b, h) + aoff + m * 2048 + k * 1024); } while (0)
#define PG8_LDB(dst, b, h) do { _Pragma("unroll") for (int n = 0; n < 2; ++n) _Pragma("unroll") for (int k = 0; k < 2; ++k) dst[n][k] = *(const PG8_LAS bf16x8*)(lds + PG8_SB(b, h) + boff + n * 2048 + k * 1024); } while (0)
#define PG8_MMA(ai, bj, At, Bt) do { __builtin_amdgcn_s_setprio(1); _Pragma("unroll") for (int m = 0; m < 4; ++m) _Pragma("unroll") for (int n = 0; n < 2; ++n) _Pragma("unroll") for (int k = 0; k < 2; ++k) \
        acc[ai][bj][m][n] = __builtin_amdgcn_mfma_f32_16x16x32_bf16(Bt[n][k], At[m][k], acc[ai][bj][m][n], 0, 0, 0); __builtin_amdgcn_s_setprio(0); } while (0)
#define PG8_WAIT_V(n) asm volatile("s_waitcnt vmcnt(" #n ")" ::: "memory")
#define PG8_WAIT_L(n) asm volatile("s_waitcnt lgkmcnt(" #n ")" ::: "memory")
#define PG8_BAR __builtin_amdgcn_s_barrier()
#define PG8_SCHED __builtin_amdgcn_sched_barrier(0)
    Unit cur, nxt; int ui = 0;
    if (!S.next(0, cur)) return;
    f32x4 acc[2][2][4][2];
#pragma unroll
    for (int a = 0; a < 2; ++a)
#pragma unroll
        for (int b = 0; b < 2; ++b)
#pragma unroll
            for (int m = 0; m < 4; ++m)
#pragma unroll
                for (int n = 0; n < 2; ++n) acc[a][b][m][n] = (f32x4){0.f, 0.f, 0.f, 0.f};
    bf16x8 At[4][2], B0[2][2], B1[2][2];
    const char* cA = (const char*)g.A + (size_t)cur.pm * tstepA; const char* cB = (const char*)g.Bt + (size_t)cur.pn * tstepB;
    S.a_ready(cur);
    if constexpr (SP2) {
        PG8_STAGE(PG8_SB(0, 0), cB, voffB); PG8_STAGE(PG8_SB(0, 1), cB + hstepB, voffB); PG8_STAGE(PG8_SA(0, 0), cA, voffA); PG8_STAGE(PG8_SA(0, 1), cA + hstepA, voffA);
        if (wr == 1) PG8_BAR;
        PG8_WAIT_V(2); PG8_BAR;
        PG8_STAGE(PG8_SB(1, 0), cB + kstep, voffB); PG8_STAGE(PG8_SA(1, 0), cA + kstep, voffA); PG8_STAGE(PG8_SB(1, 1), cB + hstepB + kstep, voffB);
        PG8_WAIT_V(6); PG8_BAR;
    } else {
        PG8_STAGE(PG8_SB(0, 0), cB, voffB); PG8_STAGE(PG8_SA(0, 0), cA, voffA); PG8_STAGE(PG8_SB(0, 1), cB + hstepB, voffB); PG8_STAGE(PG8_SA(0, 1), cA + hstepA, voffA);
        if (wr == 1) PG8_BAR;
        PG8_WAIT_V(4); PG8_BAR;
        PG8_STAGE(PG8_SB(1, 0), cB + kstep, voffB); PG8_STAGE(PG8_SA(1, 0), cA + kstep, voffA); PG8_STAGE(PG8_SB(1, 1), cB + hstepB + kstep, voffB);
        PG8_WAIT_V(6); PG8_BAR;
    }
    for (;;) {
        const bool has_next = S.next(ui + 1, nxt);
        const char* nA = has_next ? (const char*)g.A + (size_t)nxt.pm * tstepA : cA; const char* nB = has_next ? (const char*)g.Bt + (size_t)nxt.pn * tstepB : cB;
        for (int t = 0; t < nt; t += 2) {
            const bool last = (t == nt - 2);
            const char* a1 = cA + (size_t)((t + 1) >> 2) * g.apst + (size_t)((t + 1) & 3) * kstep;
            const char* a2 = last ? nA : cA + (size_t)((t + 2) >> 2) * g.apst + (size_t)((t + 2) & 3) * kstep; const char* b2 = last ? nB : cB + (size_t)(t + 2) * kstep;
            const char* a3 = a2 + kstep; const char* b3 = b2 + kstep;
            if (last && has_next) S.a_ready(nxt);
            if constexpr (Mid::ON) { if (t == mid.t_at) mid(acc, cur, wr, wc, fr, fq); }
            if constexpr (SP2) {
            PG8_LDB(B0, 0, 0); PG8_LDB(B1, 0, 1); PG8_SCHED; PG8_LDA(At, 0, 0); PG8_STAGE(PG8_SA(1, 1), a1 + hstepA, voffA);
            PG8_WAIT_V(8); PG8_WAIT_L(0); PG8_BAR; PG8_MMA(0, 0, At, B0); PG8_MMA(0, 1, At, B1); PG8_BAR; PG8_SCHED;
            PG8_LDA(At, 0, 1); PG8_STAGE(PG8_SB(0, 0), b2, voffB); PG8_STAGE(PG8_SB(0, 1), b2 + hstepB, voffB); PG8_STAGE(PG8_SA(0, 0), a2, voffA);
            PG8_WAIT_V(8); PG8_WAIT_L(0); PG8_BAR; PG8_MMA(1, 0, At, B0); PG8_MMA(1, 1, At, B1); PG8_BAR; PG8_SCHED;
            PG8_LDB(B0, 1, 0); PG8_LDB(B1, 1, 1); PG8_SCHED; PG8_LDA(At, 1, 0); PG8_STAGE(PG8_SA(0, 1), a2 + hstepA, voffA);
            PG8_WAIT_V(8); PG8_WAIT_L(0); PG8_BAR; PG8_MMA(0, 0, At, B0); PG8_MMA(0, 1, At, B1); PG8_BAR; PG8_SCHED;
            PG8_LDA(At, 1, 1); PG8_STAGE(PG8_SB(1, 0), b3, voffB); PG8_STAGE(PG8_SB(1, 1), b3 + hstepB, voffB); PG8_STAGE(PG8_SA(1, 0), a3, voffA);
            PG8_WAIT_V(8); PG8_WAIT_L(0); PG8_BAR; PG8_MMA(1, 0, At, B0); PG8_MMA(1, 1, At, B1); PG8_BAR; PG8_SCHED;
            } else {
            PG8_LDB(B0, 0, 0); PG8_SCHED; PG8_LDA(At, 0, 0); PG8_STAGE(PG8_SA(1, 1), a1 + hstepA, voffA);
            PG8_WAIT_L(8); PG8_BAR; PG8_WAIT_L(0); PG8_MMA(0, 0, At, B0); PG8_BAR; PG8_SCHED;
            PG8_LDB(B1, 0, 1); PG8_STAGE(PG8_SB(0, 0), b2, voffB);
            PG8_BAR; PG8_WAIT_L(0); PG8_MMA(0, 1, At, B1); PG8_BAR;
            PG8_LDA(At, 0, 1); PG8_STAGE(PG8_SA(0, 0), a2, voffA);
            PG8_BAR; PG8_WAIT_L(0); PG8_MMA(1, 0, At, B0); PG8_BAR; PG8_SCHED;
            PG8_STAGE(PG8_SB(0, 1), b2 + hstepB, voffB);
            PG8_WAIT_V(6); PG8_BAR; PG8_MMA(1, 1, At, B1); PG8_BAR;
            PG8_LDB(B0, 1, 0); PG8_SCHED; PG8_LDA(At, 1, 0); PG8_STAGE(PG8_SA(0, 1), a2 + hstepA, voffA);
            PG8_WAIT_L(8); PG8_BAR; PG8_WAIT_L(0); PG8_MMA(0, 0, At, B0); PG8_BAR; PG8_SCHED;
            PG8_LDB(B1, 1, 1); PG8_STAGE(PG8_SB(1, 0), b3, voffB);
            PG8_BAR; PG8_WAIT_L(0); PG8_MMA(0, 1, At, B1); PG8_BAR;
            PG8_LDA(At, 1, 1); PG8_STAGE(PG8_SA(1, 0), a3, voffA);
            PG8_BAR; PG8_WAIT_L(0); PG8_MMA(1, 0, At, B0); PG8_BAR; PG8_SCHED;
            PG8_STAGE(PG8_SB(1, 1), b3 + hstepB, voffB);
            PG8_WAIT_V(6); PG8_BAR; PG8_MMA(1, 1, At, B1); PG8_BAR;
            }
        }
        if constexpr (ALIGN_EPI) { if (wr == 0) PG8_BAR; }
        if constexpr (!Epi::AFTER_DRAIN) { E(acc, cur, wr, wc, fr, fq); S.done(cur); }
        if (!has_next) break;
#pragma unroll
        for (int a = 0; a < 2; ++a)
#pragma unroll
            for (int b = 0; b < 2; ++b)
#pragma unroll
                for (int m = 0; m < 4; ++m)
#pragma unroll
                    for (int n = 0; n < 2; ++n) acc[a][b][m][n] = (f32x4){0.f, 0.f, 0.f, 0.f};
        cur = nxt; cA = nA; cB = nB; ++ui;
        if constexpr (ALIGN_EPI) { if (wr == 1) PG8_BAR; }
    }
    PG8_WAIT_V(0);
    if constexpr (!ALIGN_EPI) { if (wr == 0) PG8_BAR; }
    PG8_BAR;
    if constexpr (Epi::AFTER_DRAIN) { E.fused(acc, cur, wr, wc, fr, fq, lds, wid, lane); S.done(cur); }
#undef PG8_SA
#undef PG8_SB
#undef PG8_STAGE
#undef PG8_LDA
#undef PG8_LDB
#undef PG8_MMA
#undef PG8_WAIT_V
#undef PG8_WAIT_L
#undef PG8_BAR
#undef PG8_SCHED
}
}

constexpr int DM = 2048, SEQ = 2048, NB = 16, MTOK = NB * SEQ;
constexpr int INW = 11776, FF = 5632, FF2 = 11264;
constexpr int C_RQ = 0, C_RK = 1024, C_RV = 2048, C_RG = 4096, C_SQ = 6144, C_SK = 7168, C_SV = 7424, C_GR = 7680, C_GS = 9728;
constexpr float RMS_EPS = 1e-6f;
constexpr size_t PST = (size_t)MTOK * 256;
constexpr int PN_RQ = 0, PN_RK = 4, PN_RV = 8, PN_RG = 16, PN_SQ = 24, PN_SK = 28, PN_SV = 29, PN_GR = 30, PN_GS = 38, PN_UG = 22;
constexpr size_t MiB = (size_t)1 << 20;
constexpr size_t WS_CTL = 0, WS_CTL_BYTES = 16384;
constexpr size_t WS_WIN = 1 * MiB, WS_WRO = 47 * MiB  , WS_WOUT = 59 * MiB, WS_WUP = 67 * MiB;
constexpr size_t WS_H = 133 * MiB, WS_PROJ = 261 * MiB, WS_WDN = 997 * MiB, WS_ROPE = 1019 * MiB, WS_Y2 = 1 * MiB, WS_END = 1021 * MiB;
constexpr size_t WS_EDGE = WS_PROJ + 400 * MiB;
constexpr size_t WS_Y1 = WS_PROJ + 448 * MiB;
constexpr size_t WS_RSTD1 = 1020 * MiB;
constexpr int LDS_BYTES = 147456;
constexpr int NWAVES = 8, NTHR = 512;

typedef unsigned short bf16;
typedef float f32x4 __attribute__((ext_vector_type(4)));
typedef unsigned u32x4 __attribute__((ext_vector_type(4)));
typedef unsigned u32x2 __attribute__((ext_vector_type(2)));
#define LAS __attribute__((address_space(3)))
#define LDS_WAIT() asm volatile("s_waitcnt lgkmcnt(0)" ::: "memory")

__device__ __forceinline__ float bf2f(bf16 b) { return __uint_as_float(((unsigned)b) << 16); }
__device__ __forceinline__ unsigned f2bf(float f) { unsigned u = __float_as_uint(f); return (u + 0x7fffu + ((u >> 16) & 1u)) >> 16; }
__device__ __forceinline__ unsigned pk2(float lo, float hi) { typedef float f2_t __attribute__((ext_vector_type(2))); typedef __bf16 b2_t __attribute__((ext_vector_type(2))); f2_t v = {lo, hi}; b2_t b = __builtin_convertvector(v, b2_t); return __builtin_bit_cast(unsigned, b); }
__device__ __forceinline__ float wave_sum(float v) {
#pragma unroll
    for (int o = 1; o < 64; o <<= 1) v += __shfl_xor(v, o);
    return v;
}
__device__ __forceinline__ float wave_max(float v) {
#pragma unroll
    for (int o = 1; o < 64; o <<= 1) v = fmaxf(v, __shfl_xor(v, o));
    return v;
}

struct Args {
    const float *x, *g_pre_mix, *w_in, *w_ret_o, *w_swa_o, *w_out, *sinks, *g_post_mix, *g_pre_ffn, *w_up, *conv_w, *conv_b, *w_down, *g_post_ffn;
    float* out; unsigned char* ws;
};

template <bool UPPERM> __device__ __forceinline__ void p0_transpose_item(const float* W, int K, int N, bf16* WT, LAS float* scr, int item, int lane, int ldk = 0, int koff = 0) {
    const int nblk = N / 32, kb = item / nblk, nb = item % nblk, k0 = 64 * kb, n0 = 32 * nb;
    const int sn0 = UPPERM ? ((n0 >> 7) & 1) * FF + 128 * (n0 >> 8) + (n0 & 127) : n0;
#pragma unroll 8
    for (int i = 0; i < 32; ++i) { const int kk = 2 * i + (lane >> 5); scr[kk * 33 + (lane & 31)] = W[(size_t)(k0 + kk) * N + sn0 + (lane & 31)]; }
    LDS_WAIT();
    const int c = lane & 7;
#pragma unroll
    for (int j = 0; j < 4; ++j) { const int n = (lane >> 3) + 8 * j; const LAS float* s = scr + (8 * c) * 33 + n;
        u32x4 o; o.x = pk2(s[0 * 33], s[1 * 33]); o.y = pk2(s[2 * 33], s[3 * 33]); o.z = pk2(s[4 * 33], s[5 * 33]); o.w = pk2(s[6 * 33], s[7 * 33]);
        *(u32x4*)(WT + (size_t)(n0 + n) * (ldk ? ldk : K) + koff + k0 + 8 * c) = o; }
    LDS_WAIT();
}
__device__ __forceinline__ void rms_row_to_bf16(const float* xrow, const float* g, bf16* orow, int lane) {
    const f32x4* xr = (const f32x4*)xrow + lane; f32x4 v[8]; float s = 0.f;
#pragma unroll
    for (int j = 0; j < 8; ++j) { v[j] = xr[64 * j]; s += (v[j].x * v[j].x + v[j].y * v[j].y) + (v[j].z * v[j].z + v[j].w * v[j].w); }
    const float rstd = rsqrtf(wave_sum(s) * (1.f / DM) + RMS_EPS);
    u32x2* o8 = (u32x2*)orow + lane;
#pragma unroll
    for (int j = 0; j < 8; ++j) { const f32x4 gv = ((const f32x4*)g)[lane + 64 * j]; u32x2 w; w.x = pk2(v[j].x * rstd * gv.x, v[j].y * rstd * gv.y); w.y = pk2(v[j].z * rstd * gv.z, v[j].w * rstd * gv.w); o8[64 * j] = w; }
}
__device__ __forceinline__ void p0_prologue(const Args& a, LAS unsigned char* lds, int G, const int swave) {
    const int lane = lane_id_asm(), wave = swave, tid = wave * 64 + lane;
    LAS float* scr = (LAS float*)(lds + wave * 16384);
    const int gw = blockIdx.x * NWAVES + wave, NGW = G * NWAVES;
    constexpr int I_IN = (DM / 64) * (INW / 32), I_RO = (DM / 64) * (DM / 32), I_SO = (1024 / 64) * (DM / 32), I_OUT = I_RO, I_UP = (DM / 64) * (FF2 / 32), I_DN = (FF / 64) * (DM / 32);
    constexpr int NITEMS = I_IN + I_RO + I_SO + I_OUT + I_UP + I_DN;
    unsigned char* ws = a.ws;
    for (int it = gw; it < NITEMS; it += NGW) {
        int r = it;
        if (r < I_IN) { p0_transpose_item<false>(a.w_in, DM, INW, (bf16*)(ws + WS_WIN), scr, r, lane); continue; } r -= I_IN;
        if (r < I_RO) { p0_transpose_item<false>(a.w_ret_o, DM, DM, (bf16*)(ws + WS_WRO), scr, r, lane, 3072, 0); continue; } r -= I_RO;
        if (r < I_SO) { p0_transpose_item<false>(a.w_swa_o, 1024, DM, (bf16*)(ws + WS_WRO), scr, r, lane, 3072, 2048);   continue; } r -= I_SO;
        if (r < I_OUT) { p0_transpose_item<false>(a.w_out, DM, DM, (bf16*)(ws + WS_WOUT), scr, r, lane); continue; } r -= I_OUT;
        if (r < I_UP) { p0_transpose_item<true>(a.w_up, DM, FF2, (bf16*)(ws + WS_WUP), scr, r, lane); continue; } r -= I_UP;
        p0_transpose_item<false>(a.w_down, FF, DM, (bf16*)(ws + WS_WDN), scr, r, lane);
    }
    for (int m = gw; m < MTOK; m += NGW) rms_row_to_bf16(a.x + (size_t)m * DM, a.g_pre_mix, (bf16*)(ws + WS_H) + (size_t)m * DM, lane);
    float* rc = (float*)(ws + WS_ROPE); float* rs = rc + SEQ * 64;
    for (int e = blockIdx.x * NTHR + tid; e < SEQ * 64; e += G * NTHR) {
        const int pos = e >> 6, i = e & 63;
        const float inv = 1.0f / powf(10000.0f, (float)(2 * i) / 128.0f);
        const float ang = (float)pos * inv;
        const double rev = (double)ang * 0.15915494309189533577; const float fr = (float)(rev - floor(rev));
        rc[e] = __builtin_amdgcn_cosf(fr); rs[e] = __builtin_amdgcn_sinf(fr);
    }
}

__device__ __forceinline__ void unpack8(const u32x4 w, float (&f)[8]) { f[0] = pg8::bf_lo(w.x); f[1] = pg8::bf_hi(w.x); f[2] = pg8::bf_lo(w.y); f[3] = pg8::bf_hi(w.y); f[4] = pg8::bf_lo(w.z); f[5] = pg8::bf_hi(w.z); f[6] = pg8::bf_lo(w.w); f[7] = pg8::bf_hi(w.w); }
typedef float f32x16 __attribute__((ext_vector_type(16)));
typedef short bf16x8v __attribute__((ext_vector_type(8)));
typedef float f32x2v __attribute__((ext_vector_type(2)));
typedef __bf16 bf16x2v __attribute__((ext_vector_type(2)));
#define MFMA32(a, b, c) __builtin_amdgcn_mfma_f32_32x32x16_bf16((a), (b), (c), 0, 0, 0)
__device__ __forceinline__ int crow(int i, int h) { return (i & 3) + 8 * (i >> 2) + 4 * h; }
__device__ __forceinline__ unsigned cvtpk(float lo, float hi) { f32x2v v = {lo, hi}; bf16x2v b = __builtin_convertvector(v, bf16x2v); return __builtin_bit_cast(unsigned, b); }
__device__ __forceinline__ bf16x8v pack_step(const f32x16& x, int s) {
    u32x4 p; p.x = cvtpk(x[8 * s], x[8 * s + 1]); p.y = cvtpk(x[8 * s + 2], x[8 * s + 3]); p.z = cvtpk(x[8 * s + 4], x[8 * s + 5]); p.w = cvtpk(x[8 * s + 6], x[8 * s + 7]);
    return __builtin_bit_cast(bf16x8v, p);
}
__device__ __forceinline__ void lds_barrier() { asm volatile("s_waitcnt lgkmcnt(0)\n\ts_barrier" ::: "memory"); }
constexpr int RET_RS = 272;
constexpr int RET_TILE = 128 * RET_RS;
typedef short s16x4v __attribute__((ext_vector_type(4)));
__device__ __forceinline__ s16x4v lds_tr(const LAS unsigned char* p) { return __builtin_bit_cast(s16x4v, __builtin_amdgcn_ds_read_tr16_b64_v4i16((LAS s16x4v*)p)); }
__device__ __forceinline__ bf16x8v cat8(s16x4v lo, s16x4v hi) { return __builtin_shufflevector(lo, hi, 0, 1, 2, 3, 4, 5, 6, 7); }
__device__ __forceinline__ void ret_mfma(LAS unsigned char* lds, bf16* proj, const float* rc, const float* rs, int b, int hd, const int swave) {
    LAS unsigned char* Qs = lds; LAS unsigned char* Ks = lds + RET_TILE; LAS unsigned char* Ps = lds + 2 * RET_TILE;
    LAS float* red = (LAS float*)(lds + 3 * RET_TILE);
    const int lane = lane_id_asm(), w = swave, tid = w * 64 + lane, r = lane & 31, h = lane >> 5;
    LAS unsigned char* vs = lds + 3 * RET_TILE + 4096 + w * 4096;
    const int i16 = lane & 15, q4 = i16 >> 2, p4 = i16 & 3, blk = (lane >> 4) & 1;
    const int troff = (8 * h + q4) * 64 + 32 * blk + 8 * p4;
    const int ktr = (8 * h + q4) * RET_RS + (16 * blk + 4 * p4) * 2;
    const float lg = log2f(1.0f - exp2f(-5.0f - (float)hd));
    f32x16 X[4];
#pragma unroll
    for (int t = 0; t < 4; ++t)
#pragma unroll
        for (int i = 0; i < 16; ++i) X[t][i] = 0.f;
    for (int n = 0; n < SEQ / 128; ++n) {
        const size_t row0 = (size_t)b * SEQ + (size_t)n * 128;
#pragma unroll 1
        for (int which = 0; which < 2; ++which) {
#pragma unroll
            for (int it = 0; it < 2; ++it) { const int task = tid + 512 * it, tok = task >> 3, d0 = (task & 7) * 8;
                const bf16* p = proj + (size_t)(which * 4 + (hd >> 1)) * PST + (row0 + tok) * 256 + (hd & 1) * 128;
                float x1[8], x2[8]; unpack8(*(const u32x4*)(p + d0), x1); unpack8(*(const u32x4*)(p + d0 + 64), x2);
                const float* cp = rc + (size_t)(n * 128 + tok) * 64 + d0; const float* sp = rs + (size_t)(n * 128 + tok) * 64 + d0;
                const f32x4 c0 = *(const f32x4*)cp, c1 = *(const f32x4*)(cp + 4), s0 = *(const f32x4*)sp, s1 = *(const f32x4*)(sp + 4);
                const float cs[8] = {c0.x, c0.y, c0.z, c0.w, c1.x, c1.y, c1.z, c1.w}, sn[8] = {s0.x, s0.y, s0.z, s0.w, s1.x, s1.y, s1.z, s1.w};
                const float sc = which ? 0.08838834764831845f * __builtin_amdgcn_exp2f(lg * (float)(127 - tok)) : 1.0f;
                float y1[8], y2[8];
#pragma unroll
                for (int e = 0; e < 8; ++e) { y1[e] = (x1[e] * cs[e] - x2[e] * sn[e]) * sc; y2[e] = (x1[e] * sn[e] + x2[e] * cs[e]) * sc; }
                LAS unsigned char* base = which ? Ks : Qs;
                u32x4 o1, o2; o1.x = cvtpk(y1[0], y1[1]); o1.y = cvtpk(y1[2], y1[3]); o1.z = cvtpk(y1[4], y1[5]); o1.w = cvtpk(y1[6], y1[7]);
                o2.x = cvtpk(y2[0], y2[1]); o2.y = cvtpk(y2[2], y2[3]); o2.z = cvtpk(y2[4], y2[5]); o2.w = cvtpk(y2[6], y2[7]);
                *(LAS u32x4*)(base + tok * RET_RS + d0 * 2) = o1; *(LAS u32x4*)(base + tok * RET_RS + (d0 + 64) * 2) = o2; } }
        u32x4 vraw[8];
        { int l2 = lane; asm volatile("" : "+v"(l2));
          const bf16* vp = proj + (size_t)(PN_RV + hd) * PST + (row0 + 16 * 0) * 256 + 32 * w + (unsigned)((l2 >> 2) * 256 + 8 * (l2 & 3));
#pragma unroll
          for (int s = 0; s < 8; ++s) vraw[s] = *(const u32x4*)(vp + (16 * s) * 256); }
        lds_barrier();
        for (int bi = w; bi < 10; bi += 8) { const int qb = bi < 1 ? 0 : (bi < 3 ? 1 : (bi < 6 ? 2 : 3)), kb = bi - (qb * (qb + 1)) / 2;
            f32x16 x;
#pragma unroll
            for (int i = 0; i < 16; ++i) x[i] = 0.f;
#pragma unroll
            for (int s = 0; s < 8; ++s) { const bf16x8v ka = *(const LAS bf16x8v*)(Ks + (32 * kb + r) * RET_RS + (16 * s + 8 * h) * 2); const bf16x8v qv = *(const LAS bf16x8v*)(Qs + (32 * qb + r) * RET_RS + (16 * s + 8 * h) * 2); x = MFMA32(ka, qv, x); }
            const float qsc = __builtin_amdgcn_exp2f(lg * (float)(32 * qb + r - 127));
#pragma unroll
            for (int g = 0; g < 4; ++g) { float pv[4];
#pragma unroll
                for (int e = 0; e < 4; ++e) { const int i = 4 * g + e; const int d = 32 * (qb - kb) + r - crow(i, h); pv[e] = d >= 0 ? x[i] * qsc : 0.f; }
                u32x2 pw; pw.x = cvtpk(pv[0], pv[1]); pw.y = cvtpk(pv[2], pv[3]);
                *(LAS u32x2*)(Ps + (32 * qb + r) * RET_RS + (32 * kb + 8 * g + 4 * h) * 2) = pw; } }
        bf16x8v Vf[8];
#pragma unroll
        for (int hf = 0; hf < 2; ++hf) {
#pragma unroll
            for (int s4 = 0; s4 < 4; ++s4) *(LAS u32x4*)(vs + s4 * 1024 + lane * 16) = vraw[4 * hf + s4];
            LDS_WAIT();
#pragma unroll
            for (int s4 = 0; s4 < 4; ++s4) Vf[4 * hf + s4] = cat8(lds_tr(vs + s4 * 1024 + troff), lds_tr(vs + s4 * 1024 + troff + 256));
            LDS_WAIT();
        }
        bf16x8v Sp[4][2];
#pragma unroll
        for (int t = 0; t < 4; ++t) { Sp[t][0] = pack_step(X[t], 0); Sp[t][1] = pack_step(X[t], 1); }
        u32x2 gwn[4];
#pragma unroll
        for (int g = 0; g < 4; ++g) gwn[g] = *(const u32x2*)(proj + (size_t)(PN_RG + hd) * PST + (row0 + r) * 256 + 32 * w + 8 * g + 4 * h);
        lds_barrier();
#pragma unroll
        for (int qb = 0; qb < 4; ++qb) {
            f32x16 zi, zc;
#pragma unroll
            for (int i = 0; i < 16; ++i) { zi[i] = 0.f; zc[i] = 0.f; }
            u32x2 gwc[4];
#pragma unroll
            for (int g = 0; g < 4; ++g) { gwc[g] = gwn[g]; if (qb < 3) gwn[g] = *(const u32x2*)(proj + (size_t)(PN_RG + hd) * PST + (row0 + 32 * (qb + 1) + r) * 256 + 32 * w + 8 * g + 4 * h); }
#pragma unroll
            for (int kb = 0; kb <= qb; ++kb)
#pragma unroll
                for (int s2 = 0; s2 < 2; ++s2) { const bf16x8v pq = *(const LAS bf16x8v*)(Ps + (32 * qb + r) * RET_RS + (32 * kb + 16 * s2 + 8 * h) * 2); zi = MFMA32(Vf[2 * kb + s2], pq, zi); }
#pragma unroll
            for (int t = 0; t < 4; ++t)
#pragma unroll
                for (int s2 = 0; s2 < 2; ++s2) { const LAS unsigned char* qp = Qs + (32 * qb + r) * RET_RS + (32 * t + 16 * s2 + 4 * h) * 2;
                    const u32x2 lo = *(const LAS u32x2*)qp, hi = *(const LAS u32x2*)(qp + 16); u32x4 qq; qq.x = lo.x; qq.y = lo.y; qq.z = hi.x; qq.w = hi.y;
                    zc = MFMA32(Sp[t][s2], __builtin_bit_cast(bf16x8v, qq), zc); }
            const float xi = __builtin_amdgcn_exp2f(lg * (float)(32 * qb + r + 1));
            float ssq = 0.f;
#pragma unroll
            for (int i = 0; i < 16; ++i) { zi[i] = zi[i] + xi * zc[i]; ssq += zi[i] * zi[i]; }
            ssq += __shfl_xor(ssq, 32);
            if (h == 0) red[(32 * qb + r) * 8 + w] = ssq;
            lds_barrier();
            const f32x4 ra = *(const LAS f32x4*)(red + (32 * qb + r) * 8), rb = *(const LAS f32x4*)(red + (32 * qb + r) * 8 + 4);
            const float rstd = rsqrtf(((ra.x + ra.y) + (ra.z + ra.w) + (rb.x + rb.y) + (rb.z + rb.w)) * (1.f / 256.f) + RMS_EPS);
#pragma unroll
            for (int g = 0; g < 4; ++g) { const u32x2 gw = gwc[g];
                u32x2* op = (u32x2*)(proj + (size_t)(PN_RG + hd) * PST + (row0 + 32 * qb + r) * 256 + 32 * w + 8 * g + 4 * h);
                const float g0 = pg8::bf_lo(gw.x), g1 = pg8::bf_hi(gw.x), g2 = pg8::bf_lo(gw.y), g3 = pg8::bf_hi(gw.y);
                u32x2 ow; ow.x = cvtpk(g0 * zi[4 * g] * rstd, g1 * zi[4 * g + 1] * rstd); ow.y = cvtpk(g2 * zi[4 * g + 2] * rstd, g3 * zi[4 * g + 3] * rstd);
                *op = ow; }
        }
        { const float dec = __builtin_amdgcn_exp2f(lg * 128.f);
#pragma unroll
          for (int t = 0; t < 4; ++t) {
#pragma unroll
              for (int i = 0; i < 16; ++i) X[t][i] *= dec;
#pragma unroll
              for (int s = 0; s < 8; ++s) { const LAS unsigned char* kp = Ks + ktr + (16 * s) * RET_RS + (32 * t) * 2; X[t] = MFMA32(cat8(lds_tr(kp), lds_tr(kp + 4 * RET_RS)), Vf[s], X[t]); } } }
        lds_barrier();
    }
}

constexpr int SW_RS = 144;
__device__ __forceinline__ void swa_mfma(LAS unsigned char* lds, bf16* proj, const float* sinks, int unit0, int ustride, const int swave) {
    const int lane = lane_id_asm(), w = swave, tid = w * 64 + lane, r = lane & 31, h = lane >> 5;
    const int i16 = lane & 15, q4 = i16 >> 2, p4 = i16 & 3, blk = (lane >> 4) & 1;
    LAS unsigned char* Kb = lds; LAS unsigned char* Vb = lds + 256 * SW_RS;
    const int g = w >> 1, qh = w & 1;
    const int vtr = (4 * h + q4) * SW_RS + (16 * blk + 4 * p4) * 2;
    for (int u = unit0; u < NB * 4 * (SEQ / 128); u += ustride) {
        const int n = u & 15, hk = (u >> 4) & 3, b = u >> 6;
        const size_t rowb = (size_t)b * SEQ + (size_t)n * 128;
#pragma unroll
        for (int it = 0; it < 4; ++it) { const int pi = tid + 512 * it, row = pi >> 3, c8 = pi & 7;
            u32x4 kv = {0u, 0u, 0u, 0u}, vv = {0u, 0u, 0u, 0u};
            if (n > 0 || row >= 128) { const bf16* p = proj + (size_t)PN_SK * PST + (rowb + row - 128) * 256 + hk * 64 + c8 * 8; kv = *(const u32x4*)p; vv = *(const u32x4*)(p + PST); }
            *(LAS u32x4*)(Kb + row * SW_RS + c8 * 16) = kv; *(LAS u32x4*)(Vb + row * SW_RS + c8 * 16) = vv; }
        lds_barrier();
        const float sk = sinks[hk * 4 + g];
#pragma unroll 1
        for (int qg = 0; qg < 2; ++qg) { const int p0 = 64 * qh + 32 * qg, kb0 = 2 * qh + qg;
            bf16* qrow = proj + (size_t)(PN_SQ + hk) * PST + (rowb + p0 + r) * 256 + g * 64;
            bf16x8v qf[4];
#pragma unroll
            for (int s = 0; s < 4; ++s) qf[s] = *(const bf16x8v*)(qrow + 16 * s + 8 * h);
            f32x16 x[5];
#pragma unroll
            for (int j = 0; j < 5; ++j) {
#pragma unroll
                for (int i = 0; i < 16; ++i) x[j][i] = 0.f;
#pragma unroll
                for (int s = 0; s < 4; ++s) { const bf16x8v ka = *(const LAS bf16x8v*)(Kb + (32 * (kb0 + j) + r) * SW_RS + (16 * s + 8 * h) * 2); x[j] = MFMA32(ka, qf[s], x[j]); } }
            float m = -INFINITY;
#pragma unroll
            for (int j = 0; j < 5; ++j) { const float boff = ((n > 0) || (kb0 + j >= 4)) ? 0.f : -INFINITY;
#pragma unroll
                for (int i = 0; i < 16; ++i) { float a = x[j][i] * 0.125f + boff;
                    if (j == 0) a = (crow(i, h) > r) ? a : -INFINITY;
                    if (j == 4) a = (crow(i, h) <= r) ? a : -INFINITY;
                    x[j][i] = a; m = fmaxf(m, a); } }
            m = fmaxf(m, __shfl_xor(m, 32)); m = fmaxf(m, sk);
            float sum = 0.f;
#pragma unroll
            for (int j = 0; j < 5; ++j)
#pragma unroll
                for (int i = 0; i < 16; ++i) { const float e = __expf(x[j][i] - m); x[j][i] = e; sum += e; }
            sum += __shfl_xor(sum, 32);
            const float inv = 1.0f / (sum + __expf(sk - m));
            f32x16 o[2];
#pragma unroll
            for (int i = 0; i < 16; ++i) { o[0][i] = 0.f; o[1][i] = 0.f; }
#pragma unroll
            for (int j = 0; j < 5; ++j)
#pragma unroll
                for (int s = 0; s < 2; ++s) { const bf16x8v pb = pack_step(x[j], s);
#pragma unroll
                    for (int db = 0; db < 2; ++db) { const LAS unsigned char* vp = Vb + vtr + (32 * (kb0 + j) + 16 * s) * SW_RS + (32 * db) * 2;
                        o[db] = MFMA32(cat8(lds_tr(vp), lds_tr(vp + 8 * SW_RS)), pb, o[db]); } }
#pragma unroll
            for (int db = 0; db < 2; ++db)
#pragma unroll
                for (int gq = 0; gq < 4; ++gq) { u32x2 wv; wv.x = cvtpk(o[db][4 * gq] * inv, o[db][4 * gq + 1] * inv); wv.y = cvtpk(o[db][4 * gq + 2] * inv, o[db][4 * gq + 3] * inv);
                    *(u32x2*)(qrow + 32 * db + 8 * gq + 4 * h) = wv; }
        }
        lds_barrier();
    }
}

__device__ __forceinline__ void p4n_rows(const Args& a, int G, const int swave) {
    const int lane = lane_id_asm(), wave = swave; const int gw = blockIdx.x * NWAVES + wave, NGW = G * NWAVES;
    bf16* H = (bf16*)(a.ws + WS_H); float* rstd1 = (float*)(a.ws + WS_RSTD1);
    for (int m0 = gw; m0 < MTOK; m0 += 2 * NGW) {
        f32x4 v[2][8], xv[2][8];
#pragma unroll
        for (int rr = 0; rr < 2; ++rr) { const int m = (m0 + rr * NGW < MTOK) ? m0 + rr * NGW : m0;
            const u32x2* yb = (const u32x2*)((const bf16*)(a.ws + WS_Y1) + (size_t)m * 256) + lane; const f32x4* xr = (const f32x4*)(a.x + (size_t)m * DM) + lane;
#pragma unroll
            for (int j = 0; j < 8; ++j) { const u32x2 yw = yb[(PST / 4) * j]; v[rr][j] = (f32x4){pg8::bf_lo(yw.x), pg8::bf_hi(yw.x), pg8::bf_lo(yw.y), pg8::bf_hi(yw.y)}; xv[rr][j] = xr[64 * j]; } }
#pragma unroll
        for (int rr = 0; rr < 2; ++rr) { const int m = m0 + rr * NGW; if (m >= MTOK) break;
            float s = 0.f;
#pragma unroll
            for (int j = 0; j < 8; ++j) s += (v[rr][j].x * v[rr][j].x + v[rr][j].y * v[rr][j].y) + (v[rr][j].z * v[rr][j].z + v[rr][j].w * v[rr][j].w);
            const float rstd = rsqrtf(wave_sum(s) * (1.f / DM) + RMS_EPS); float s2 = 0.f;
            if (lane == 0) rstd1[m] = rstd;
#pragma unroll
            for (int j = 0; j < 8; ++j) { const f32x4 gv = ((const f32x4*)a.g_post_mix)[lane + 64 * j]; const f32x4 t = xv[rr][j] + v[rr][j] * rstd * gv; v[rr][j] = t;
                s2 += (t.x * t.x + t.y * t.y) + (t.z * t.z + t.w * t.w); }
            const float rstd2 = rsqrtf(wave_sum(s2) * (1.f / DM) + RMS_EPS);
            u32x2* o8 = (u32x2*)(H + (size_t)m * DM) + lane;
#pragma unroll
            for (int j = 0; j < 8; ++j) { const f32x4 gv = ((const f32x4*)a.g_pre_ffn)[lane + 64 * j]; const f32x4 t = v[rr][j]; u32x2 w; w.x = pk2(t.x * rstd2 * gv.x, t.y * rstd2 * gv.y); w.y = pk2(t.z * rstd2 * gv.z, t.w * rstd2 * gv.w); o8[64 * j] = w; } }
    }
}
__device__ __forceinline__ void p6n_rows(const Args& a, int G, const int swave) {
    const int lane = lane_id_asm(), wave = swave; const int gw = blockIdx.x * NWAVES + wave, NGW = G * NWAVES;
    const bf16* Y2 = (const bf16*)(a.ws + WS_Y2); const bf16* Y1 = (const bf16*)(a.ws + WS_Y1); const float* rstd1 = (const float*)(a.ws + WS_RSTD1);
    for (int m = gw; m < MTOK; m += NGW) {
        f32x4 v[8], y1v[8], xv[8];
        const u32x2* yb = (const u32x2*)(Y2 + (size_t)m * 256) + lane; const u32x2* y1b = (const u32x2*)(Y1 + (size_t)m * 256) + lane; const f32x4* xr = (const f32x4*)(a.x + (size_t)m * DM) + lane;
        const float r1 = rstd1[m];
#pragma unroll
        for (int j = 0; j < 8; ++j) { const u32x2 yw = yb[(PST / 4) * j], zw = y1b[(PST / 4) * j];
            v[j] = (f32x4){pg8::bf_lo(yw.x), pg8::bf_hi(yw.x), pg8::bf_lo(yw.y), pg8::bf_hi(yw.y)}; y1v[j] = (f32x4){pg8::bf_lo(zw.x), pg8::bf_hi(zw.x), pg8::bf_lo(zw.y), pg8::bf_hi(zw.y)}; xv[j] = xr[64 * j]; }
        f32x4* orow = (f32x4*)(a.out + (size_t)m * DM) + lane; float s = 0.f;
#pragma unroll
        for (int j = 0; j < 8; ++j) s += (v[j].x * v[j].x + v[j].y * v[j].y) + (v[j].z * v[j].z + v[j].w * v[j].w);
        const float rstd = rsqrtf(wave_sum(s) * (1.f / DM) + RMS_EPS);
#pragma unroll
        for (int j = 0; j < 8; ++j) { const f32x4 g1 = ((const f32x4*)a.g_post_mix)[lane + 64 * j], g2 = ((const f32x4*)a.g_post_ffn)[lane + 64 * j];
            const f32x4 x1 = xv[j] + y1v[j] * r1 * g1; orow[64 * j] = x1 + v[j] * rstd * g2; }
    }
}
__device__ __forceinline__ void p5f_fixup(const Args& a, int G, const int swave) {
    const int tid = swave * 64 + lane_id_asm();
    bf16* Gp = (bf16*)(a.ws + WS_PROJ); const bf16* edge = (const bf16*)(a.ws + WS_EDGE);
    constexpr int NT = (MTOK / 64) * 44 * 16;
    for (int task = blockIdx.x * NTHR + tid; task < NT; task += G * NTHR) {
        const int pc = task & 15, pn = (task >> 4) % 44, Gi = task / (16 * 44); const int ct = pc * 8, C = pn * 128 + ct;
        float wv[3][8], wg[3][8], bv[8], bg[8];
#pragma unroll
        for (int k = 0; k < 3; ++k)
#pragma unroll
            for (int e = 0; e < 8; ++e) { wv[k][e] = a.conv_w[k * FF2 + C + e]; wg[k][e] = a.conv_w[k * FF2 + FF + C + e]; }
#pragma unroll
        for (int e = 0; e < 8; ++e) { bv[e] = a.conv_b[C + e]; bg[e] = a.conv_b[FF + C + e]; }
        float pv2[8], pv1[8], pg2[8], pg1[8], cv0[8], cg0[8], cv1[8], cg1[8];
        if ((Gi & 31) == 0) {
#pragma unroll
            for (int e = 0; e < 8; ++e) { pv2[e] = 0.f; pv1[e] = 0.f; pg2[e] = 0.f; pg1[e] = 0.f; }
        } else { const bf16* ep = edge + ((size_t)((Gi - 1) * 4 + 2) * 44 + pn) * 256 + ct;
            unpack8(*(const u32x4*)ep, pv2); unpack8(*(const u32x4*)(ep + 128), pg2); unpack8(*(const u32x4*)(ep + 44 * 256), pv1); unpack8(*(const u32x4*)(ep + 44 * 256 + 128), pg1); }
        { const bf16* ep = edge + ((size_t)(Gi * 4) * 44 + pn) * 256 + ct;
            unpack8(*(const u32x4*)ep, cv0); unpack8(*(const u32x4*)(ep + 128), cg0); unpack8(*(const u32x4*)(ep + 44 * 256), cv1); unpack8(*(const u32x4*)(ep + 44 * 256 + 128), cg1); }
        float o0[8], o1[8];
#pragma unroll
        for (int e = 0; e < 8; ++e) {
            const float yv0 = bv[e] + wv[0][e] * pv2[e] + wv[1][e] * pv1[e] + wv[2][e] * cv0[e], yg0 = bg[e] + wg[0][e] * pg2[e] + wg[1][e] * pg1[e] + wg[2][e] * cg0[e];
            const float yv1 = bv[e] + wv[0][e] * pv1[e] + wv[1][e] * cv0[e] + wv[2][e] * cv1[e], yg1 = bg[e] + wg[0][e] * pg1[e] + wg[1][e] * cg0[e] + wg[2][e] * cg1[e];
            o0[e] = pg8::gelu_tanh_f(yg0) * yv0; o1[e] = pg8::gelu_tanh_f(yg1) * yv1; }
        bf16* gp = Gp + (size_t)(pn >> 1) * PST + (size_t)(Gi * 64) * 256 + (pn & 1) * 128 + ct;
        u32x4 w; w.x = pk2(o0[0], o0[1]); w.y = pk2(o0[2], o0[3]); w.z = pk2(o0[4], o0[5]); w.w = pk2(o0[6], o0[7]); *(u32x4*)gp = w;
        w.x = pk2(o1[0], o1[1]); w.y = pk2(o1[2], o1[3]); w.z = pk2(o1[4], o1[5]); w.w = pk2(o1[6], o1[7]); *(u32x4*)(gp + 256) = w;
    }
}

#define XB_TMO      128
#define XB_XCNT(j)  (256  + 64 * (j))
#define XB_XSUB(j)  (1280 + 64 * (j))
#define XB_XGEN(j)  (2304 + 64 * (j))
#define XB_TOP      3328
#define XB_TOPGEN   3392
#define XCD_BAR_WORDS 3456
#define XB_SPIN_CAP (1u << 18)

__device__ __forceinline__ unsigned xb_ld(unsigned* p)              { return __hip_atomic_load(p, __ATOMIC_RELAXED, __HIP_MEMORY_SCOPE_AGENT); }
__device__ __forceinline__ unsigned xb_add(unsigned* p, unsigned v) { return __hip_atomic_fetch_add(p, v, __ATOMIC_RELAXED, __HIP_MEMORY_SCOPE_AGENT); }
__device__ __forceinline__ unsigned xb_xcc_id() { return (unsigned)__builtin_amdgcn_s_getreg((3 << 11) | 20) & 0xFu; }
#define XB_SPIN(cond, bar) do { unsigned _sp = 0; while (cond) { __builtin_amdgcn_s_sleep(1); \
    if ((++_sp & 255u) == 0u) { if (xb_ld(&(bar)[XB_TMO])) break; if (_sp > XB_SPIN_CAP) { atomicAdd(&(bar)[XB_TMO], 1u); break; } } } } while (0)

struct XcdBarrier {
    unsigned* bar; unsigned x;
    volatile LAS unsigned* st;
};

__device__ __forceinline__ XcdBarrier xcd_barrier_post(unsigned* bar, volatile LAS unsigned* st, const int swave) {
    XcdBarrier b; b.bar = bar; b.x = xb_xcc_id(); b.st = st;
    if (swave == 0 && lane_id_asm() == 0) (void)xb_add(&bar[XB_XCNT(b.x)], 1u);
    return b;
}
__device__ __forceinline__ void xcd_barrier_complete(unsigned* bar, unsigned x, unsigned& nloc, unsigned& nx) {
    const unsigned G = gridDim.x * gridDim.y * gridDim.z;
    unsigned sum, cnt, mine, sp = 0u;
    for (;;) {
        sum = 0u; cnt = 0u; mine = 0u;
#pragma unroll
        for (unsigned j = 0; j < 16; ++j) { const unsigned c = xb_ld(&bar[XB_XCNT(j)]); sum += c; cnt += (c > 0u) ? 1u : 0u; mine = (j == x) ? c : mine; }
        if (sum == G) break;
        __builtin_amdgcn_s_sleep(1);
        if ((++sp & 255u) == 0u) { if (xb_ld(&bar[XB_TMO])) break; if (sp > XB_SPIN_CAP) { atomicAdd(&bar[XB_TMO], 1u); break; } }
    }
    nloc = mine > 0u ? mine : 1u; nx = cnt > 0u ? cnt : 1u;
}

__device__ __forceinline__ void xcd_barrier(const XcdBarrier& b, const int swave) {
    asm volatile("s_waitcnt vmcnt(0)" ::: "memory");
    __syncthreads();
    if (swave == 0 && lane_id_asm() == 0) {
        unsigned* bar = b.bar;
        __builtin_amdgcn_s_waitcnt(0);
        unsigned nloc = b.st[0], nx = b.st[1];
        if (nloc == 0u) { xcd_barrier_complete(bar, b.x, nloc, nx); b.st[0] = nloc; b.st[1] = nx; }
        const unsigned old = xb_add(&bar[XB_XSUB(b.x)], 1u);
        const unsigned gen = old / nloc;
        if (old + 1u == (gen + 1u) * nloc) {
            __builtin_amdgcn_fence(__ATOMIC_RELEASE, "agent");
            asm volatile("s_waitcnt vmcnt(0)" ::: "memory");
            const unsigned og = xb_add(&bar[XB_TOP], 1u);
            const unsigned tg = og / nx;
            if (og + 1u == (tg + 1u) * nx) xb_add(&bar[XB_TOPGEN], 1u);
            else XB_SPIN(xb_ld(&bar[XB_TOPGEN]) == tg, bar);
            __builtin_amdgcn_fence(__ATOMIC_ACQUIRE, "agent");
            xb_add(&bar[XB_XGEN(b.x)], 1u);
            asm volatile("s_waitcnt vmcnt(0)" ::: "memory");
        } else {
            XB_SPIN(xb_ld(&bar[XB_XGEN(b.x)]) == gen, bar);
            __builtin_amdgcn_fence(__ATOMIC_ACQUIRE, "agent");
            asm volatile("s_waitcnt vmcnt(0)" ::: "memory");
        }
    }
    __syncthreads();
}

__global__ void __launch_bounds__(NTHR, 2) fwd_megakernel(Args a) {
    extern __shared__ __attribute__((aligned(16))) unsigned char lds_raw[];
    LAS unsigned char* lds = (LAS unsigned char*)lds_raw;
    cg::grid_group grid = cg::this_grid();
    const int G = gridDim.x;
    unsigned char* ws = a.ws;
    const int swave = __builtin_amdgcn_readfirstlane(threadIdx.x >> 6);
    volatile LAS unsigned* bst = (volatile LAS unsigned*)(lds + LDS_BYTES - 16);
    if (threadIdx.x < 4) bst[threadIdx.x] = 0u;
    __syncthreads();
    const XcdBarrier bar = xcd_barrier_post((unsigned*)(ws + WS_CTL), bst, swave);
    bf16* H = (bf16*)(ws + WS_H); bf16* PROJ = (bf16*)(ws + WS_PROJ);

    p0_prologue(a, lds, G, swave);
    if (a.ws == nullptr) grid.sync();
    xcd_barrier(bar, swave);
    { pg8::Gemm g{H, (const bf16*)(ws + WS_WIN), MTOK, INW, DM, DM, 512}; pg8::StaticOrder S; S.init(MTOK, INW, G, (int)blockIdx.x);
      pg8::EpiBf16<false> E{PROJ, 256, PST, nullptr, 0, PN_RG, PN_RG + 8};
      pg8::gemm_phase<pg8::EpiBf16<false>, pg8::StaticOrder, true, true>(lds, g, S, E, swave); }
    xcd_barrier(bar, swave);
    { const float* rc = (const float*)(ws + WS_ROPE); const float* rs = rc + SEQ * 64;
      if (blockIdx.x < 128 || G < 256) for (int u = blockIdx.x; u < 128; u += G) ret_mfma(lds, PROJ, rc, rs, u >> 3, u & 7, swave);
      const int su0 = (G >= 256) ? (int)blockIdx.x - 128 : (int)blockIdx.x, sst = (G >= 256) ? G - 128 : G;
      if (su0 >= 0) swa_mfma(lds, PROJ, a.sinks, su0, sst, swave); }
    xcd_barrier(bar, swave);
    { pg8::Gemm g{PROJ + (size_t)PN_RG * PST, (const bf16*)(ws + WS_WRO), MTOK, DM, 3072, 256, PST * 2}; pg8::StaticOrder S; S.init(MTOK, DM, G, (int)blockIdx.x);
      pg8::EpiGateOut E{PROJ + (size_t)PN_GS * PST, H, PST};
      pg8::MidGate mid{32, PROJ + (size_t)PN_GR * PST, PROJ + (size_t)PN_GS * PST, PST};
      pg8::gemm_phase<pg8::EpiGateOut, pg8::StaticOrder, true, true, pg8::MidGate>(lds, g, S, E, swave, mid); }
    xcd_barrier(bar, swave);
    { pg8::Gemm g{H, (const bf16*)(ws + WS_WOUT), MTOK, DM, DM, 256, PST * 2}; pg8::StaticOrder S; S.init(MTOK, DM, G, (int)blockIdx.x);
      pg8::EpiBf16<false> E{(bf16*)(ws + WS_Y1), 256, PST, nullptr, 0, 0, 0};
      pg8::gemm_phase<pg8::EpiBf16<false>, pg8::StaticOrder, true, true>(lds, g, S, E, swave); }
    xcd_barrier(bar, swave);
    p4n_rows(a, G, swave);
    xcd_barrier(bar, swave);
    { pg8::Gemm g{H, (const bf16*)(ws + WS_WUP), MTOK, FF2, DM, DM, 512}; pg8::StaticOrder S; S.init(MTOK, FF2, G, (int)blockIdx.x);
      pg8::EpiConv E{PROJ, PST, a.conv_w, a.conv_b, (bf16*)(ws + WS_EDGE), FF};
      pg8::gemm_phase<pg8::EpiConv, pg8::StaticOrder, true, true>(lds, g, S, E, swave); }
    xcd_barrier(bar, swave);
    p5f_fixup(a, G, swave);
    xcd_barrier(bar, swave);
    { pg8::Gemm g{PROJ, (const bf16*)(ws + WS_WDN), MTOK, DM, FF, 256, PST * 2}; pg8::StaticOrder S; S.init(MTOK, DM, G, (int)blockIdx.x);
      pg8::EpiBf16<false> E{(bf16*)(ws + WS_Y2), 256, PST, nullptr, 0, 0, 0};
      pg8::gemm_phase<pg8::EpiBf16<false>, pg8::StaticOrder, true, true>(lds, g, S, E, swave); }
    xcd_barrier(bar, swave);
    p6n_rows(a, G, swave);
}

extern "C" void kernel_launch(void* const* d_in, const int* in_sizes, int n_in, void* d_out, int out_size, void* d_ws, size_t ws_size, hipStream_t stream) {
    static int grid = 0;
    if (grid == 0) {
        if (n_in != 14 || ws_size < WS_END) { fprintf(stderr, "kernel_launch: unexpected n_in %d / ws_size %zu (need %zu)\n", n_in, ws_size, (size_t)WS_END); grid = -1; return; }
        int dev = 0, cus = 0, per_cu = 0;
        hipGetDevice(&dev); hipDeviceGetAttribute(&cus, hipDeviceAttributeMultiprocessorCount, dev);
        if (hipFuncSetAttribute((const void*)fwd_megakernel, hipFuncAttributeMaxDynamicSharedMemorySize, LDS_BYTES) != hipSuccess) { fprintf(stderr, "kernel_launch: hipFuncSetAttribute failed\n"); grid = -1; return; }
        if (hipOccupancyMaxActiveBlocksPerMultiprocessor(&per_cu, (const void*)fwd_megakernel, NTHR, LDS_BYTES) != hipSuccess || per_cu < 1) { fprintf(stderr, "kernel_launch: occupancy query says %d\n", per_cu); per_cu = 1; }
        (void)hipGetLastError();
        grid = cus * per_cu;
        fprintf(stderr, "kernel_launch: grid %d (cus %d x %d)\n", grid, cus, per_cu);
    }
    if (grid < 0) return;
    if (hipMemsetAsync((char*)d_ws + WS_CTL, 0, WS_CTL_BYTES, stream) != hipSuccess) { fprintf(stderr, "kernel_launch: memset failed\n"); return; }
    Args a{};
    a.x = (const float*)d_in[0]; a.g_pre_mix = (const float*)d_in[1]; a.w_in = (const float*)d_in[2]; a.w_ret_o = (const float*)d_in[3]; a.w_swa_o = (const float*)d_in[4];
    a.w_out = (const float*)d_in[5]; a.sinks = (const float*)d_in[6]; a.g_post_mix = (const float*)d_in[7]; a.g_pre_ffn = (const float*)d_in[8]; a.w_up = (const float*)d_in[9];
    a.conv_w = (const float*)d_in[10]; a.conv_b = (const float*)d_in[11]; a.w_down = (const float*)d_in[12]; a.g_post_ffn = (const float*)d_in[13];
    a.out = (float*)d_out; a.ws = (unsigned char*)d_ws;
    void* args[] = {&a};
    hipError_t e = hipLaunchCooperativeKernel((const void*)fwd_megakernel, dim3(grid), dim3(NTHR), args, LDS_BYTES, stream);
    if (e != hipSuccess) fprintf(stderr, "cooperative launch failed: %s (grid %d)\n", hipGetErrorString(e), grid);
}
```

```cpp
#include <hip/hip_runtime.h>
#include <hip/hip_cooperative_groups.h>
#include <cstdio>
#include <cstdint>
namespace cg = cooperative_groups;

__device__ __forceinline__ int lane_id_asm() { int l; asm volatile("v_mbcnt_lo_u32_b32 %0, -1, 0\n\tv_mbcnt_hi_u32_b32 %0, -1, %0" : "=v"(l)); return l; }
namespace pg8 {
#define PG8_LAS __attribute__((address_space(3)))
typedef unsigned short bf16_t;
typedef short bf16x8 __attribute__((ext_vector_type(8)));
typedef float f32x4 __attribute__((ext_vector_type(4)));
typedef float f32x2 __attribute__((ext_vector_type(2)));
typedef unsigned u32x4 __attribute__((ext_vector_type(4)));
typedef unsigned u32x2 __attribute__((ext_vector_type(2)));
constexpr int BM = 256, BK = 64, HALF = 128, HTB = HALF * BK * 2  , STAGE_BYTES = 8 * HTB, NXCD = 8, WGM = 8;

__host__ __device__ __forceinline__ int lds_byte(int r, int c) { const int st = (r >> 4) * 2 + (c >> 5), rr = r & 15, cc = c & 31, ob = rr * 64 + cc * 2; return st * 1024 + (ob ^ (((ob >> 9) & 1) << 5)); }
__host__ __device__ __forceinline__ void stage_rc(int b, int& R, int& C) { const int st = b / 1024, sb = b % 1024, swz = sb ^ (((sb >> 9) & 1) << 5); R = (st >> 1) * 16 + swz / 64; C = (st & 1) * 32 + (swz % 64) / 2; }
__host__ __device__ __forceinline__ int perm32(int rho) { const int n = rho >> 4, i = rho & 15; return 8 * (i >> 2) + 4 * n + (i & 3); }

struct Unit { int pm, pn; };
struct Gemm { const bf16_t* A; const bf16_t* Bt; int M, N, K, lda; size_t apst; };

struct StaticOrder {
    int nM, nN, nwg, G, c;
    __host__ __device__ void init(int M, int N, int G_, int c_) { nM = M / BM; nN = N / BM; nwg = nM * nN; G = G_; c = c_; }
    __host__ __device__ bool next(int i, Unit& u) const {
        const long L = (long)i * G + c; if (L >= nwg) return false;
        int wgid = (int)L; { const int q = nwg / NXCD, r = nwg % NXCD, xcd = wgid % NXCD, off = wgid / NXCD; wgid = (xcd < r ? xcd * (q + 1) : r * (q + 1) + (xcd - r) * q) + off; }
        const int nig = WGM * nN, gid = wgid / nig, fm = gid * WGM, gsz = (nM - fm) < WGM ? (nM - fm) : WGM;
        u.pm = fm + ((wgid % nig) % gsz); u.pn = (wgid % nig) / gsz; return true;
    }
    __device__ __forceinline__ void a_ready(const Unit&) const {}
    __device__ __forceinline__ void done(const Unit&) const {}
};

__device__ __forceinline__ unsigned cvt_pk_bf16(float lo, float hi) { unsigned r; asm volatile("v_cvt_pk_bf16_f32 %0, %1, %2" : "=v"(r) : "v"(lo), "v"(hi)); return r; }
__device__ __forceinline__ float bf_lo(unsigned w) { return __uint_as_float(w << 16); }
__device__ __forceinline__ float bf_hi(unsigned w) { return __uint_as_float(w & 0xffff0000u); }
__device__ __forceinline__ float gclamp(float x) { return fminf(fmaxf(x, -30.f), 30.f); }
__device__ __forceinline__ float sigmoidf_(float x) { return __builtin_amdgcn_rcpf(1.0f + __expf(-x)); }

template <bool HALO> struct EpiBf16 {
    static constexpr bool PERM = true, AFTER_DRAIN = false;
    bf16_t* O; int ldc; size_t pst; bf16_t* halo; int ldh;
    __device__ __forceinline__ void operator()(const f32x4 (&acc)[2][2][4][2], const Unit& u, int wr, int wc, int fr, int fq) const {
        const int row0 = u.pm * BM + wr * 64 + fr; const int colt = wc * 32 + 8 * fq; const int col0 = u.pn * BM + colt;
#pragma unroll
        for (int ai = 0; ai < 2; ++ai)
#pragma unroll
            for (int m = 0; m < 4; ++m) { bf16_t* rowp = O + (size_t)u.pn * pst + (size_t)(row0 + ai * HALF + m * 16) * ldc + colt;
#pragma unroll
                for (int bj = 0; bj < 2; ++bj) { const f32x4 v0 = acc[ai][bj][m][0], v1 = acc[ai][bj][m][1];
                    u32x4 w; w.x = cvt_pk_bf16(v0[0], v0[1]); w.y = cvt_pk_bf16(v0[2], v0[3]); w.z = cvt_pk_bf16(v1[0], v1[1]); w.w = cvt_pk_bf16(v1[2], v1[3]);
                    *(u32x4*)(rowp + bj * HALF) = w;
                    if (HALO) { if (m == 3 && wr == 1 && fr >= 14) *(u32x4*)(halo + (size_t)((u.pm * 2 + ai) * 2 + (fr - 14)) * ldh + col0 + bj * HALF) = w; } } }
    }
};
__device__ __forceinline__ float dpp_ror1(float x) { return __int_as_float(__builtin_amdgcn_mov_dpp(__float_as_int(x), 0x121, 0xf, 0xf, true)); }
__device__ __forceinline__ float dpp_ror2(float x) { return __int_as_float(__builtin_amdgcn_mov_dpp(__float_as_int(x), 0x122, 0xf, 0xf, true)); }
__device__ __forceinline__ float dpp_shr1(float old, float x) { return __int_as_float(__builtin_amdgcn_update_dpp(__float_as_int(old), __float_as_int(x), 0x111, 0xf, 0xf, false)); }
__device__ __forceinline__ float dpp_shr2(float old, float x) { return __int_as_float(__builtin_amdgcn_update_dpp(__float_as_int(old), __float_as_int(x), 0x112, 0xf, 0xf, false)); }
__device__ __forceinline__ float conv3(float b, float w0, float p2, float w1, float p1, float w2, float u) {
    float r; asm("v_fma_f32 %0, %1, %2, %3" : "=v"(r) : "v"(w0), "v"(p2), "v"(b)); asm("v_fmac_f32 %0, %1, %2" : "+v"(r) : "v"(w1), "v"(p1)); asm("v_fmac_f32 %0, %1, %2" : "+v"(r) : "v"(w2), "v"(u)); return r; }
__device__ __forceinline__ float gelu_tanh_f(float x) { const float z = x * (0.7978845608028654f + 0.035677408136300125f * x * x); return x * __builtin_amdgcn_rcpf(1.0f + __builtin_amdgcn_exp2f(-2.8853900817779268f * z)); }
struct EpiConv {
    static constexpr bool PERM = true, AFTER_DRAIN = false;
    bf16_t* Gp; size_t pst; const float* cw; const float* cb; bf16_t* edge; int ff;
    __device__ __forceinline__ void operator()(const f32x4 (&acc)[2][2][4][2], const Unit& u, int wr, int wc, int fr, int fq) const {
        const int ct = wc * 32 + 8 * fq;
        const int C = u.pn * 128 + ct;
#pragma unroll
        for (int ai = 0; ai < 2; ++ai) { const int Gi = u.pm * 4 + ai * 2 + wr;
#pragma unroll
            for (int which = 0; which < 2; ++which) { const int m = which ? 3 : 0; const bool on = which ? (fr >= 14) : (fr < 2); const int slot = which ? fr - 12 : fr;
                if (on) {
#pragma unroll
                    for (int bj = 0; bj < 2; ++bj) { const f32x4 v0 = acc[ai][bj][m][0], v1 = acc[ai][bj][m][1];
                        u32x4 w; w.x = cvt_pk_bf16(v0[0], v0[1]); w.y = cvt_pk_bf16(v0[2], v0[3]); w.z = cvt_pk_bf16(v1[0], v1[1]); w.w = cvt_pk_bf16(v1[2], v1[3]);
                        *(u32x4*)(edge + ((size_t)(Gi * 4 + slot) * 44 + u.pn) * 256 + bj * 128 + ct) = w; } } } }
        float c[2][2][4][8];
#pragma unroll
        for (int ai = 0; ai < 2; ++ai)
#pragma unroll
            for (int bj = 0; bj < 2; ++bj)
#pragma unroll
                for (int m = 0; m < 4; ++m)
#pragma unroll
                    for (int e = 0; e < 8; ++e) c[ai][bj][m][e] = acc[ai][bj][m][e >> 2][e & 3];
#pragma unroll
        for (int bj = 0; bj < 2; ++bj) { const int Cg = C + bj * ff;
            const f32x4 w0a = *(const f32x4*)(cw + Cg), w0b = *(const f32x4*)(cw + Cg + 4), w1a = *(const f32x4*)(cw + 2 * ff + Cg), w1b = *(const f32x4*)(cw + 2 * ff + Cg + 4);
            const f32x4 w2a = *(const f32x4*)(cw + 4 * ff + Cg), w2b = *(const f32x4*)(cw + 4 * ff + Cg + 4), ba = *(const f32x4*)(cb + Cg), bb = *(const f32x4*)(cb + Cg + 4);
#pragma unroll
            for (int e = 0; e < 8; ++e) { const float w0 = (e >> 2) ? w0b[e & 3] : w0a[e & 3], w1 = (e >> 2) ? w1b[e & 3] : w1a[e & 3], w2 = (e >> 2) ? w2b[e & 3] : w2a[e & 3], bs = (e >> 2) ? bb[e & 3] : ba[e & 3];
#pragma unroll
                for (int ai = 0; ai < 2; ++ai) {
                    const float u0 = c[ai][bj][0][e], u1 = c[ai][bj][1][e], u2 = c[ai][bj][2][e], u3 = c[ai][bj][3][e];
                    const float p13 = dpp_shr1(dpp_ror1(u2), u3), p12 = dpp_shr1(dpp_ror1(u1), u2), p11 = dpp_shr1(dpp_ror1(u0), u1), p10 = dpp_shr1(0.f, u0);
                    const float p23 = dpp_shr2(dpp_ror2(u2), u3), p22 = dpp_shr2(dpp_ror2(u1), u2), p21 = dpp_shr2(dpp_ror2(u0), u1), p20 = dpp_shr2(0.f, u0);
                    c[ai][bj][3][e] = conv3(bs, w0, p23, w1, p13, w2, u3);
                    c[ai][bj][2][e] = conv3(bs, w0, p22, w1, p12, w2, u2);
                    c[ai][bj][1][e] = conv3(bs, w0, p21, w1, p11, w2, u1);
                    c[ai][bj][0][e] = conv3(bs, w0, p20, w1, p10, w2, u0); } } }
        const int row0 = u.pm * BM + wr * 64 + fr;
#pragma unroll
        for (int ai = 0; ai < 2; ++ai)
#pragma unroll
            for (int m = 0; m < 4; ++m) { float o[8];
#pragma unroll
                for (int e = 0; e < 8; e += 2) { const f32x2 x = {c[ai][1][m][e], c[ai][1][m][e + 1]}, vv = {c[ai][0][m][e], c[ai][0][m][e + 1]};
                    const f32x2 arg = x * ((x * x) * (-0.10294323f) + (-2.30220819f)); f32x2 d; d.x = 1.0f + __builtin_amdgcn_exp2f(arg.x); d.y = 1.0f + __builtin_amdgcn_exp2f(arg.y);
                    f32x2 r; r.x = __builtin_amdgcn_rcpf(d.x); r.y = __builtin_amdgcn_rcpf(d.y); const f32x2 oo = (x * vv) * r; o[e] = oo.x; o[e + 1] = oo.y; }
                u32x4 w; w.x = cvt_pk_bf16(o[0], o[1]); w.y = cvt_pk_bf16(o[2], o[3]); w.z = cvt_pk_bf16(o[4], o[5]); w.w = cvt_pk_bf16(o[6], o[7]);
                if (m > 0 || fr >= 2) *(u32x4*)(Gp + (size_t)(u.pn >> 1) * pst + (size_t)(row0 + ai * HALF + m * 16) * 256 + (u.pn & 1) * 128 + ct) = w; }
    }
};

struct MidNone { static constexpr bool ON = false; int t_at; __device__ __forceinline__ void operator()(f32x4 (&)[2][2][4][2], const Unit&, int, int, int, int) const {} };
struct MidGate { static constexpr bool ON = true; int t_at; const bf16_t* Gr; const bf16_t* Gs; size_t pst;
    __device__ __forceinline__ void operator()(f32x4 (&acc)[2][2][4][2], const Unit& u, int wr, int wc, int fr_, int fq_) const {
        const int l = lane_id_asm(), fr = l & 15, fq = l >> 4;
        const int row0 = u.pm * BM + wr * 64 + fr; const int col0 = wc * 32 + 8 * fq; const size_t pb = (size_t)u.pn * pst;
#pragma unroll
        for (int ai = 0; ai < 2; ++ai)
#pragma unroll
            for (int m = 0; m < 4; ++m) { const size_t off = pb + (size_t)(row0 + ai * HALF + m * 16) * 256 + col0;
#pragma unroll
                for (int bj = 0; bj < 2; ++bj) { const u32x4 a = *(const u32x4*)(Gr + off + bj * HALF), b = *(const u32x4*)(Gs + off + bj * HALF);
                    f32x4 r0, r1;
                    r0[0] = (1.f + __expf(-gclamp(bf_lo(b.x)))) * __builtin_amdgcn_rcpf(1.f + __expf(-gclamp(bf_lo(a.x)))); r0[1] = (1.f + __expf(-gclamp(bf_hi(b.x)))) * __builtin_amdgcn_rcpf(1.f + __expf(-gclamp(bf_hi(a.x))));
                    r0[2] = (1.f + __expf(-gclamp(bf_lo(b.y)))) * __builtin_amdgcn_rcpf(1.f + __expf(-gclamp(bf_lo(a.y)))); r0[3] = (1.f + __expf(-gclamp(bf_hi(b.y)))) * __builtin_amdgcn_rcpf(1.f + __expf(-gclamp(bf_hi(a.y))));
                    r1[0] = (1.f + __expf(-gclamp(bf_lo(b.z)))) * __builtin_amdgcn_rcpf(1.f + __expf(-gclamp(bf_lo(a.z)))); r1[1] = (1.f + __expf(-gclamp(bf_hi(b.z)))) * __builtin_amdgcn_rcpf(1.f + __expf(-gclamp(bf_hi(a.z))));
                    r1[2] = (1.f + __expf(-gclamp(bf_lo(b.w)))) * __builtin_amdgcn_rcpf(1.f + __expf(-gclamp(bf_lo(a.w)))); r1[3] = (1.f + __expf(-gclamp(bf_hi(b.w)))) * __builtin_amdgcn_rcpf(1.f + __expf(-gclamp(bf_hi(a.w))));
                    acc[ai][bj][m][0] *= r0; acc[ai][bj][m][1] *= r1; } }
    }
};
struct EpiGateOut {
    static constexpr bool PERM = true, AFTER_DRAIN = false;
    const bf16_t* G; bf16_t* O; size_t pst;
    __device__ __forceinline__ void operator()(const f32x4 (&acc)[2][2][4][2], const Unit& u, int wr, int wc, int fr, int fq) const {
        const int row0 = u.pm * BM + wr * 64 + fr; const int col0 = wc * 32 + 8 * fq; const size_t pb = (size_t)u.pn * pst;
#pragma unroll
        for (int ai = 0; ai < 2; ++ai)
#pragma unroll
            for (int m = 0; m < 4; ++m) { const size_t off = pb + (size_t)(row0 + ai * HALF + m * 16) * 256 + col0;
#pragma unroll
                for (int bj = 0; bj < 2; ++bj) { const u32x4 gw = *(const u32x4*)(G + off + bj * HALF);
                    f32x4 v0 = acc[ai][bj][m][0], v1 = acc[ai][bj][m][1];
                    v0[0] *= sigmoidf_(gclamp(bf_lo(gw.x))); v0[1] *= sigmoidf_(gclamp(bf_hi(gw.x))); v0[2] *= sigmoidf_(gclamp(bf_lo(gw.y))); v0[3] *= sigmoidf_(gclamp(bf_hi(gw.y)));
                    v1[0] *= sigmoidf_(gclamp(bf_lo(gw.z))); v1[1] *= sigmoidf_(gclamp(bf_hi(gw.z))); v1[2] *= sigmoidf_(gclamp(bf_lo(gw.w))); v1[3] *= sigmoidf_(gclamp(bf_hi(gw.w)));
                    u32x4 w; w.x = cvt_pk_bf16(v0[0], v0[1]); w.y = cvt_pk_bf16(v0[2], v0[3]); w.z = cvt_pk_bf16(v1[0], v1[1]); w.w = cvt_pk_bf16(v1[2], v1[3]);
                    *(u32x4*)(O + off + bj * HALF) = w; } }
    }
};

template <class Epi, class Sched, bool ALIGN_EPI = false, bool SP2 = false, class Mid = MidNone>
__device__ __forceinline__ void gemm_phase(PG8_LAS unsigned char* lds, const Gemm g, const Sched& S, const Epi& E, const int swave, const Mid mid = Mid{}) {
    const int lane = lane_id_asm(), wid = swave, tid = wid * 64 + lane, wr = wid >> 2, wc = wid & 3, fr = lane & 15, fq = lane >> 4;
    const int K = g.K, nt = K / BK;
    unsigned voffA[2], voffB[2];
#pragma unroll
    for (int i = 0; i < 2; ++i) { int R, C; stage_rc(tid * 16 + i * 8192, R, C); const int Rb = Epi::PERM ? ((R & ~31) + perm32(R & 31)) : R;
        voffA[i] = (unsigned)(R * g.lda + C) * 2u; voffB[i] = (unsigned)(Rb * K + C) * 2u; }
    const size_t kstep = (size_t)(BK * 2);
    const size_t hstepA = (size_t)HALF * g.lda * 2, hstepB = (size_t)HALF * K * 2;
    const size_t tstepA = 2 * hstepA, tstepB = 2 * hstepB;
    const unsigned ldsw = (unsigned)wid * 1024u;
    const int aoff = lds_byte(wr * 64 + fr, fq * 8), boff = lds_byte(wc * 32 + fr, fq * 8);
#define PG8_SA(b, h) (((b) * 2 + (h)) * HTB)
#define PG8_SB(b, h) ((4 + (b) * 2 + (h)) * HTB)
#define PG8_STAGE(bufoff, gbase, voff) do { _Pragma("unroll") for (int _i = 0; _i < 2; ++_i) \
        __builtin_amdgcn_global_load_lds((const unsigned*)((const char*)(gbase) + (voff)[_i]), (PG8_LAS unsigned*)(lds + (bufoff) + ldsw + _i * 8192), 16, 0, 0); } while (0)
#define PG8_LDA(dst, b, h) do { _Pragma("unroll") for (int m = 0; m < 4; ++m) _Pragma("unroll") for (int k = 0; k < 2; ++k) dst[m][k] = *(const PG8_LAS bf16x8*)(lds + PG8_SA(b, h) + aoff + m * 2048 + k * 1024); } while (0)
#define PG8_LDB(dst, b, h) do { _Pragma("unroll") for (int n = 0; n < 2; ++n) _Pragma("unroll") for (int k = 0; k < 2; ++k) dst[n][k] = *(const PG8_LAS bf16x8*)(lds + PG8_SB(b, h) + boff + n * 2048 + k * 1024); } while (0)
#define PG8_MMA(ai, bj, At, Bt) do { __builtin_amdgcn_s_setprio(1); _Pragma("unroll") for (int m = 0; m < 4; ++m) _Pragma("unroll") for (int n = 0; n < 2; ++n) _Pragma("unroll") for (int k = 0; k < 2; ++k) \
        acc[ai][bj][m][n] = __builtin_amdgcn_mfma_f32_16x16x32_bf16(Bt[n][k], At[m][k], acc[ai][bj][m][n], 0, 0, 0); __builtin_amdgcn_s_setprio(0); } while (0)
#define PG8_WAIT_V(n) asm volatile("s_waitcnt vmcnt(" #n ")" ::: "memory")
#define PG8_WAIT_L(n) asm volatile("s_waitcnt lgkmcnt(" #n ")" ::: "memory")
#define PG8_BAR __builtin_amdgcn_s_barrier()
#define PG8_SCHED __builtin_amdgcn_sched_barrier(0)
    Unit cur, nxt; int ui = 0;
    if (!S.next(0, cur)) return;
    f32x4 acc[2][2][4][2];
#pragma unroll
    for (int a = 0; a < 2; ++a)
#pragma unroll
        for (int b = 0; b < 2; ++b)
#pragma unroll
            for (int m = 0; m < 4; ++m)
#pragma unroll
                for (int n = 0; n < 2; ++n) acc[a][b][m][n] = (f32x4){0.f, 0.f, 0.f, 0.f};
    bf16x8 At[4][2], B0[2][2], B1[2][2];
    const char* cA = (const char*)g.A + (size_t)cur.pm * tstepA; const char* cB = (const char*)g.Bt + (size_t)cur.pn * tstepB;
    S.a_ready(cur);
    if constexpr (SP2) {
        PG8_STAGE(PG8_SB(0, 0), cB, voffB); PG8_STAGE(PG8_SB(0, 1), cB + hstepB, voffB); PG8_STAGE(PG8_SA(0, 0), cA, voffA); PG8_STAGE(PG8_SA(0, 1), cA + hstepA, voffA);
        if (wr == 1) PG8_BAR;
        PG8_WAIT_V(2); PG8_BAR;
        PG8_STAGE(PG8_SB(1, 0), cB + kstep, voffB); PG8_STAGE(PG8_SA(1, 0), cA + kstep, voffA); PG8_STAGE(PG8_SB(1, 1), cB + hstepB + kstep, voffB);
        PG8_WAIT_V(6); PG8_BAR;
    } else {
        PG8_STAGE(PG8_SB(0, 0), cB, voffB); PG8_STAGE(PG8_SA(0, 0), cA, voffA); PG8_STAGE(PG8_SB(0, 1), cB + hstepB, voffB); PG8_STAGE(PG8_SA(0, 1), cA + hstepA, voffA);
        if (wr == 1) PG8_BAR;
        PG8_WAIT_V(4); PG8_BAR;
        PG8_STAGE(PG8_SB(1, 0), cB + kstep, voffB); PG8_STAGE(PG8_SA(1, 0), cA + kstep, voffA); PG8_STAGE(PG8_SB(1, 1), cB + hstepB + kstep, voffB);
        PG8_WAIT_V(6); PG8_BAR;
    }
    for (;;) {
        const bool has_next = S.next(ui + 1, nxt);
        const char* nA = has_next ? (const char*)g.A + (size_t)nxt.pm * tstepA : cA; const char* nB = has_next ? (const char*)g.Bt + (size_t)nxt.pn * tstepB : cB;
        for (int t = 0; t < nt; t += 2) {
            const bool last = (t == nt - 2);
            const char* a1 = cA + (size_t)((t + 1) >> 2) * g.apst + (size_t)((t + 1) & 3) * kstep;
            const char* a2 = last ? nA : cA + (size_t)((t + 2) >> 2) * g.apst + (size_t)((t + 2) & 3) * kstep; const char* b2 = last ? nB : cB + (size_t)(t + 2) * kstep;
            const char* a3 = a2 + kstep; const char* b3 = b2 + kstep;
            if (last && has_next) S.a_ready(nxt);
            if constexpr (Mid::ON) { if (t == mid.t_at) mid(acc, cur, wr, wc, fr, fq); }
            if constexpr (SP2) {
            PG8_LDB(B0, 0, 0); PG8_LDB(B1, 0, 1); PG8_SCHED; PG8_LDA(At, 0, 0); PG8_STAGE(PG8_SA(1, 1), a1 + hstepA, voffA);
            PG8_WAIT_V(8); PG8_WAIT_L(0); PG8_BAR; PG8_MMA(0, 0, At, B0); PG8_MMA(0, 1, At, B1); PG8_BAR; PG8_SCHED;
            PG8_LDA(At, 0, 1); PG8_STAGE(PG8_SB(0, 0), b2, voffB); PG8_STAGE(PG8_SB(0, 1), b2 + hstepB, voffB); PG8_STAGE(PG8_SA(0, 0), a2, voffA);
            PG8_WAIT_V(8); PG8_WAIT_L(0); PG8_BAR; PG8_MMA(1, 0, At, B0); PG8_MMA(1, 1, At, B1); PG8_BAR; PG8_SCHED;
            PG8_LDB(B0, 1, 0); PG8_LDB(B1, 1, 1); PG8_SCHED; PG8_LDA(At, 1, 0); PG8_STAGE(PG8_SA(0, 1), a2 + hstepA, voffA);
            PG8_WAIT_V(8); PG8_WAIT_L(0); PG8_BAR; PG8_MMA(0, 0, At, B0); PG8_MMA(0, 1, At, B1); PG8_BAR; PG8_SCHED;
            PG8_LDA(At, 1, 1); PG8_STAGE(PG8_SB(1, 0), b3, voffB); PG8_STAGE(PG8_SB(1, 1), b3 + hstepB, voffB); PG8_STAGE(PG8_SA(1, 0), a3, voffA);
            PG8_WAIT_V(8); PG8_WAIT_L(0); PG8_BAR; PG8_MMA(1, 0, At, B0); PG8_MMA(1, 1, At, B1); PG8_BAR; PG8_SCHED;
            } else {
            PG8_LDB(B0, 0, 0); PG8_SCHED; PG8_LDA(At, 0, 0); PG8_STAGE(PG8_SA(1, 1), a1 + hstepA, voffA);
            PG8_WAIT_L(8); PG8_BAR; PG8_WAIT_L(0); PG8_MMA(0, 0, At, B0); PG8_BAR; PG8_SCHED;
            PG8_LDB(B1, 0, 1); PG8_STAGE(PG8_SB(0, 0), b2, voffB);
            PG8_BAR; PG8_WAIT_L(0); PG8_MMA(0, 1, At, B1); PG8_BAR;
            PG8_LDA(At, 0, 1); PG8_STAGE(PG8_SA(0, 0), a2, voffA);
            PG8_BAR; PG8_WAIT_L(0); PG8_MMA(1, 0, At, B0); PG8_BAR; PG8_SCHED;
            PG8_STAGE(PG8_SB(0, 1), b2 + hstepB, voffB);
            PG8_WAIT_V(6); PG8_BAR; PG8_MMA(1, 1, At, B1); PG8_BAR;
            PG8_LDB(B0, 1, 0); PG8_SCHED; PG8_LDA(At, 1, 0); PG8_STAGE(PG8_SA(0, 1), a2 + hstepA, voffA);
            PG8_WAIT_L(8); PG8_BAR; PG8_WAIT_L(0); PG8_MMA(0, 0, At, B0); PG8_BAR; PG8_SCHED;
            PG8_LDB(B1, 1, 1); PG8_STAGE(PG8_SB(1, 0), b3, voffB);
            PG8_BAR; PG8_WAIT_L(0); PG8_MMA(0, 1, At, B1); PG8_BAR;
            PG8_LDA(At, 1, 1); PG8_STAGE(PG8_SA(1, 0), a3, voffA);
            PG8_BAR; PG8_WAIT_L(0); PG8_MMA(1, 0, At, B0); PG8_BAR; PG8_SCHED;
            PG8_STAGE(PG8_SB(1, 1), b3 + hstepB, voffB);
            PG8_WAIT_V(6); PG8_BAR; PG8_MMA(1, 1, At, B1); PG8_BAR;
            }
        }
        if constexpr (ALIGN_EPI) { if (wr == 0) PG8_BAR; }
        if constexpr (!Epi::AFTER_DRAIN) { E(acc, cur, wr, wc, fr, fq); S.done(cur); }
        if (!has_next) break;
#pragma unroll
        for (int a = 0; a < 2; ++a)
#pragma unroll
            for (int b = 0; b < 2; ++b)
#pragma unroll
                for (int m = 0; m < 4; ++m)
#pragma unroll
                    for (int n = 0; n < 2; ++n) acc[a][b][m][n] = (f32x4){0.f, 0.f, 0.f, 0.f};
        cur = nxt; cA = nA; cB = nB; ++ui;
        if constexpr (ALIGN_EPI) { if (wr == 1) PG8_BAR; }
    }
    PG8_WAIT_V(0);
    if constexpr (!ALIGN_EPI) { if (wr == 0) PG8_BAR; }
    PG8_BAR;
    if constexpr (Epi::AFTER_DRAIN) { E.fused(acc, cur, wr, wc, fr, fq, lds, wid, lane); S.done(cur); }
#undef PG8_SA
#undef PG8_SB
#undef PG8_STAGE
#undef PG8_LDA
#undef PG8_LDB
#undef PG8_MMA
#undef PG8_WAIT_V
#undef PG8_WAIT_L
#undef PG8_BAR
#undef PG8_SCHED
}
}

constexpr int DM = 2048, SEQ = 2048, NB = 16, MTOK = NB * SEQ;
constexpr int INW = 11776, FF = 5632, FF2 = 11264;
constexpr int C_RQ = 0, C_RK = 1024, C_RV = 2048, C_RG = 4096, C_SQ = 6144, C_SK = 7168, C_SV = 7424, C_GR = 7680, C_GS = 9728;
constexpr float RMS_EPS = 1e-6f;
constexpr size_t PST = (size_t)MTOK * 256;
constexpr int PN_RQ = 0, PN_RK = 4, PN_RV = 8, PN_RG = 16, PN_SQ = 24, PN_SK = 28, PN_SV = 29, PN_GR = 30, PN_GS = 38, PN_UG = 22;
constexpr size_t MiB = (size_t)1 << 20;
constexpr size_t WS_CTL = 0, WS_CTL_BYTES = 16384;
constexpr size_t WS_WIN = 1 * MiB, WS_WRO = 47 * MiB  , WS_WOUT = 59 * MiB, WS_WUP = 67 * MiB;
constexpr size_t WS_H = 133 * MiB, WS_PROJ = 261 * MiB, WS_WDN = 997 * MiB, WS_ROPE = 1019 * MiB, WS_Y2 = 1 * MiB, WS_END = 1021 * MiB;
constexpr size_t WS_EDGE = WS_PROJ + 400 * MiB;
constexpr size_t WS_Y1 = WS_PROJ + 448 * MiB;
constexpr size_t WS_RSTD1 = 1020 * MiB;
constexpr int LDS_BYTES = 147456;
constexpr int NWAVES = 8, NTHR = 512;

typedef unsigned short bf16;
typedef float f32x4 __attribute__((ext_vector_type(4)));
typedef unsigned u32x4 __attribute__((ext_vector_type(4)));
typedef unsigned u32x2 __attribute__((ext_vector_type(2)));
#define LAS __attribute__((address_space(3)))
#define LDS_WAIT() asm volatile("s_waitcnt lgkmcnt(0)" ::: "memory")

__device__ __forceinline__ float bf2f(bf16 b) { return __uint_as_float(((unsigned)b) << 16); }
__device__ __forceinline__ unsigned f2bf(float f) { unsigned u = __float_as_uint(f); return (u + 0x7fffu + ((u >> 16) & 1u)) >> 16; }
__device__ __forceinline__ unsigned pk2(float lo, float hi) { typedef float f2_t __attribute__((ext_vector_type(2))); typedef __bf16 b2_t __attribute__((ext_vector_type(2))); f2_t v = {lo, hi}; b2_t b = __builtin_convertvector(v, b2_t); return __builtin_bit_cast(unsigned, b); }
__device__ __forceinline__ float wave_sum(float v) {
#pragma unroll
    for (int o = 1; o < 64; o <<= 1) v += __shfl_xor(v, o);
    return v;
}
__device__ __forceinline__ float wave_max(float v) {
#pragma unroll
    for (int o = 1; o < 64; o <<= 1) v = fmaxf(v, __shfl_xor(v, o));
    return v;
}

struct Args {
    const float *x, *g_pre_mix, *w_in, *w_ret_o, *w_swa_o, *w_out, *sinks, *g_post_mix, *g_pre_ffn, *w_up, *conv_w, *conv_b, *w_down, *g_post_ffn;
    float* out; unsigned char* ws;
};

template <bool UPPERM> __device__ __forceinline__ void p0_transpose_item(const float* W, int K, int N, bf16* WT, LAS float* scr, int item, int lane, int ldk = 0, int koff = 0) {
    const int nblk = N / 32, kb = item / nblk, nb = item % nblk, k0 = 64 * kb, n0 = 32 * nb;
    const int sn0 = UPPERM ? ((n0 >> 7) & 1) * FF + 128 * (n0 >> 8) + (n0 & 127) : n0;
#pragma unroll 8
    for (int i = 0; i < 32; ++i) { const int kk = 2 * i + (lane >> 5); scr[kk * 33 + (lane & 31)] = __builtin_nontemporal_load(W + (size_t)(k0 + kk) * N + sn0 + (lane & 31)); }
    LDS_WAIT();
    const int c = lane & 7;
#pragma unroll
    for (int j = 0; j < 4; ++j) { const int n = (lane >> 3) + 8 * j; const LAS float* s = scr + (8 * c) * 33 + n;
        u32x4 o; o.x = pk2(s[0 * 33], s[1 * 33]); o.y = pk2(s[2 * 33], s[3 * 33]); o.z = pk2(s[4 * 33], s[5 * 33]); o.w = pk2(s[6 * 33], s[7 * 33]);
        *(u32x4*)(WT + (size_t)(n0 + n) * (ldk ? ldk : K) + koff + k0 + 8 * c) = o; }
    LDS_WAIT();
}
__device__ __forceinline__ void rms_row_to_bf16(const float* xrow, const float* g, bf16* orow, int lane) {
    const f32x4* xr = (const f32x4*)xrow + lane; f32x4 v[8]; float s = 0.f;
#pragma unroll
    for (int j = 0; j < 8; ++j) { v[j] = __builtin_nontemporal_load(xr + 64 * j); s += (v[j].x * v[j].x + v[j].y * v[j].y) + (v[j].z * v[j].z + v[j].w * v[j].w); }
    const float rstd = rsqrtf(wave_sum(s) * (1.f / DM) + RMS_EPS);
    u32x2* o8 = (u32x2*)orow + lane;
#pragma unroll
    for (int j = 0; j < 8; ++j) { const f32x4 gv = ((const f32x4*)g)[lane + 64 * j]; u32x2 w; w.x = pk2(v[j].x * rstd * gv.x, v[j].y * rstd * gv.y); w.y = pk2(v[j].z * rstd * gv.z, v[j].w * rstd * gv.w); o8[64 * j] = w; }
}
__device__ __forceinline__ void p0_prologue(const Args& a, LAS unsigned char* lds, int G, const int swave) {
    const int lane = lane_id_asm(), wave = swave, tid = wave * 64 + lane;
    LAS float* scr = (LAS float*)(lds + wave * 16384);
    const int gw = blockIdx.x * NWAVES + wave, NGW = G * NWAVES;
    constexpr int I_IN = (DM / 64) * (INW / 32), I_RO = (DM / 64) * (DM / 32), I_SO = (1024 / 64) * (DM / 32), I_OUT = I_RO, I_UP = (DM / 64) * (FF2 / 32), I_DN = (FF / 64) * (DM / 32);
    constexpr int NITEMS = I_IN + I_RO + I_SO + I_OUT + I_UP + I_DN;
    unsigned char* ws = a.ws;
    for (int it = gw; it < NITEMS; it += NGW) {
        int r = it;
        if (r < I_IN) { p0_transpose_item<false>(a.w_in, DM, INW, (bf16*)(ws + WS_WIN), scr, r, lane); continue; } r -= I_IN;
        if (r < I_RO) { p0_transpose_item<false>(a.w_ret_o, DM, DM, (bf16*)(ws + WS_WRO), scr, r, lane, 3072, 0); continue; } r -= I_RO;
        if (r < I_SO) { p0_transpose_item<false>(a.w_swa_o, 1024, DM, (bf16*)(ws + WS_WRO), scr, r, lane, 3072, 2048);   continue; } r -= I_SO;
        if (r < I_OUT) { p0_transpose_item<false>(a.w_out, DM, DM, (bf16*)(ws + WS_WOUT), scr, r, lane); continue; } r -= I_OUT;
        if (r < I_UP) { p0_transpose_item<true>(a.w_up, DM, FF2, (bf16*)(ws + WS_WUP), scr, r, lane); continue; } r -= I_UP;
        p0_transpose_item<false>(a.w_down, FF, DM, (bf16*)(ws + WS_WDN), scr, r, lane);
    }
    for (int m = gw; m < MTOK; m += NGW) rms_row_to_bf16(a.x + (size_t)m * DM, a.g_pre_mix, (bf16*)(ws + WS_H) + (size_t)m * DM, lane);
    float* rc = (float*)(ws + WS_ROPE); float* rs = rc + SEQ * 64;
    for (int e = blockIdx.x * NTHR + tid; e < SEQ * 64; e += G * NTHR) {
        const int pos = e >> 6, i = e & 63;
        const float inv = 1.0f / powf(10000.0f, (float)(2 * i) / 128.0f);
        const float ang = (float)pos * inv;
        const double rev = (double)ang * 0.15915494309189533577; const float fr = (float)(rev - floor(rev));
        rc[e] = __builtin_amdgcn_cosf(fr); rs[e] = __builtin_amdgcn_sinf(fr);
    }
}

__device__ __forceinline__ void unpack8(const u32x4 w, float (&f)[8]) { f[0] = pg8::bf_lo(w.x); f[1] = pg8::bf_hi(w.x); f[2] = pg8::bf_lo(w.y); f[3] = pg8::bf_hi(w.y); f[4] = pg8::bf_lo(w.z); f[5] = pg8::bf_hi(w.z); f[6] = pg8::bf_lo(w.w); f[7] = pg8::bf_hi(w.w); }
typedef float f32x16 __attribute__((ext_vector_type(16)));
typedef short bf16x8v __attribute__((ext_vector_type(8)));
typedef float f32x2v __attribute__((ext_vector_type(2)));
typedef __bf16 bf16x2v __attribute__((ext_vector_type(2)));
#define MFMA32(a, b, c) __builtin_amdgcn_mfma_f32_32x32x16_bf16((a), (b), (c), 0, 0, 0)
__device__ __forceinline__ int crow(int i, int h) { return (i & 3) + 8 * (i >> 2) + 4 * h; }
__device__ __forceinline__ unsigned cvtpk(float lo, float hi) { f32x2v v = {lo, hi}; bf16x2v b = __builtin_convertvector(v, bf16x2v); return __builtin_bit_cast(unsigned, b); }
__device__ __forceinline__ bf16x8v pack_step(const f32x16& x, int s) {
    u32x4 p; p.x = cvtpk(x[8 * s], x[8 * s + 1]); p.y = cvtpk(x[8 * s + 2], x[8 * s + 3]); p.z = cvtpk(x[8 * s + 4], x[8 * s + 5]); p.w = cvtpk(x[8 * s + 6], x[8 * s + 7]);
    return __builtin_bit_cast(bf16x8v, p);
}
__device__ __forceinline__ void lds_barrier() { asm volatile("s_waitcnt lgkmcnt(0)\n\ts_barrier" ::: "memory"); }
constexpr int RET_RS = 272;
constexpr int RET_TILE = 128 * RET_RS;
typedef short s16x4v __attribute__((ext_vector_type(4)));
__device__ __forceinline__ s16x4v lds_tr(const LAS unsigned char* p) { return __builtin_bit_cast(s16x4v, __builtin_amdgcn_ds_read_tr16_b64_v4i16((LAS s16x4v*)p)); }
__device__ __forceinline__ bf16x8v cat8(s16x4v lo, s16x4v hi) { return __builtin_shufflevector(lo, hi, 0, 1, 2, 3, 4, 5, 6, 7); }
__device__ __forceinline__ void ret_mfma(LAS unsigned char* lds, bf16* proj, const float* rc, const float* rs, int b, int hd, const int swave) {
    LAS unsigned char* Qs = lds; LAS unsigned char* Ks = lds + RET_TILE; LAS unsigned char* Ps = lds + 2 * RET_TILE;
    LAS float* red = (LAS float*)(lds + 3 * RET_TILE);
    const int lane = lane_id_asm(), w = swave, tid = w * 64 + lane, r = lane & 31, h = lane >> 5;
    LAS unsigned char* vs = lds + 3 * RET_TILE + 4096 + w * 4096;
    const int i16 = lane & 15, q4 = i16 >> 2, p4 = i16 & 3, blk = (lane >> 4) & 1;
    const int troff = (8 * h + q4) * 64 + 32 * blk + 8 * p4;
    const int ktr = (8 * h + q4) * RET_RS + (16 * blk + 4 * p4) * 2;
    const float lg = log2f(1.0f - exp2f(-5.0f - (float)hd));
    f32x16 X[4];
#pragma unroll
    for (int t = 0; t < 4; ++t)
#pragma unroll
        for (int i = 0; i < 16; ++i) X[t][i] = 0.f;
    for (int n = 0; n < SEQ / 128; ++n) {
        const size_t row0 = (size_t)b * SEQ + (size_t)n * 128;
#pragma unroll 1
        for (int which = 0; which < 2; ++which) {
#pragma unroll
            for (int it = 0; it < 2; ++it) { const int task = tid + 512 * it, tok = task >> 3, d0 = (task & 7) * 8;
                const bf16* p = proj + (size_t)(which * 4 + (hd >> 1)) * PST + (row0 + tok) * 256 + (hd & 1) * 128;
                float x1[8], x2[8]; unpack8(*(const u32x4*)(p + d0), x1); unpack8(*(const u32x4*)(p + d0 + 64), x2);
                const float* cp = rc + (size_t)(n * 128 + tok) * 64 + d0; const float* sp = rs + (size_t)(n * 128 + tok) * 64 + d0;
                const f32x4 c0 = *(const f32x4*)cp, c1 = *(const f32x4*)(cp + 4), s0 = *(const f32x4*)sp, s1 = *(const f32x4*)(sp + 4);
                const float cs[8] = {c0.x, c0.y, c0.z, c0.w, c1.x, c1.y, c1.z, c1.w}, sn[8] = {s0.x, s0.y, s0.z, s0.w, s1.x, s1.y, s1.z, s1.w};
                const float sc = which ? 0.08838834764831845f * __builtin_amdgcn_exp2f(lg * (float)(127 - tok)) : 1.0f;
                float y1[8], y2[8];
#pragma unroll
                for (int e = 0; e < 8; ++e) { y1[e] = (x1[e] * cs[e] - x2[e] * sn[e]) * sc; y2[e] = (x1[e] * sn[e] + x2[e] * cs[e]) * sc; }
                LAS unsigned char* base = which ? Ks : Qs;
                u32x4 o1, o2; o1.x = cvtpk(y1[0], y1[1]); o1.y = cvtpk(y1[2], y1[3]); o1.z = cvtpk(y1[4], y1[5]); o1.w = cvtpk(y1[6], y1[7]);
                o2.x = cvtpk(y2[0], y2[1]); o2.y = cvtpk(y2[2], y2[3]); o2.z = cvtpk(y2[4], y2[5]); o2.w = cvtpk(y2[6], y2[7]);
                *(LAS u32x4*)(base + tok * RET_RS + d0 * 2) = o1; *(LAS u32x4*)(base + tok * RET_RS + (d0 + 64) * 2) = o2; } }
        u32x4 vraw[8];
        { int l2 = lane; asm volatile("" : "+v"(l2));
          const bf16* vp = proj + (size_t)(PN_RV + hd) * PST + (row0 + 16 * 0) * 256 + 32 * w + (unsigned)((l2 >> 2) * 256 + 8 * (l2 & 3));
#pragma unroll
          for (int s = 0; s < 8; ++s) vraw[s] = *(const u32x4*)(vp + (16 * s) * 256); }
        lds_barrier();
        for (int bi = w; bi < 10; bi += 8) { const int qb = bi < 1 ? 0 : (bi < 3 ? 1 : (bi < 6 ? 2 : 3)), kb = bi - (qb * (qb + 1)) / 2;
            f32x16 x;
#pragma unroll
            for (int i = 0; i < 16; ++i) x[i] = 0.f;
#pragma unroll
            for (int s = 0; s < 8; ++s) { const bf16x8v ka = *(const LAS bf16x8v*)(Ks + (32 * kb + r) * RET_RS + (16 * s + 8 * h) * 2); const bf16x8v qv = *(const LAS bf16x8v*)(Qs + (32 * qb + r) * RET_RS + (16 * s + 8 * h) * 2); x = MFMA32(ka, qv, x); }
            const float qsc = __builtin_amdgcn_exp2f(lg * (float)(32 * qb + r - 127));
#pragma unroll
            for (int g = 0; g < 4; ++g) { float pv[4];
#pragma unroll
                for (int e = 0; e < 4; ++e) { const int i = 4 * g + e; const int d = 32 * (qb - kb) + r - crow(i, h); pv[e] = d >= 0 ? x[i] * qsc : 0.f; }
                u32x2 pw; pw.x = cvtpk(pv[0], pv[1]); pw.y = cvtpk(pv[2], pv[3]);
                *(LAS u32x2*)(Ps + (32 * qb + r) * RET_RS + (32 * kb + 8 * g + 4 * h) * 2) = pw; } }
        bf16x8v Vf[8];
#pragma unroll
        for (int hf = 0; hf < 2; ++hf) {
#pragma unroll
            for (int s4 = 0; s4 < 4; ++s4) *(LAS u32x4*)(vs + s4 * 1024 + lane * 16) = vraw[4 * hf + s4];
            LDS_WAIT();
#pragma unroll
            for (int s4 = 0; s4 < 4; ++s4) Vf[4 * hf + s4] = cat8(lds_tr(vs + s4 * 1024 + troff), lds_tr(vs + s4 * 1024 + troff + 256));
            LDS_WAIT();
        }
        bf16x8v Sp[4][2];
#pragma unroll
        for (int t = 0; t < 4; ++t) { Sp[t][0] = pack_step(X[t], 0); Sp[t][1] = pack_step(X[t], 1); }
        u32x2 gwn[4];
#pragma unroll
        for (int g = 0; g < 4; ++g) gwn[g] = *(const u32x2*)(proj + (size_t)(PN_RG + hd) * PST + (row0 + r) * 256 + 32 * w + 8 * g + 4 * h);
        lds_barrier();
#pragma unroll
        for (int qb = 0; qb < 4; ++qb) {
            f32x16 zi, zc;
#pragma unroll
            for (int i = 0; i < 16; ++i) { zi[i] = 0.f; zc[i] = 0.f; }
            u32x2 gwc[4];
#pragma unroll
            for (int g = 0; g < 4; ++g) { gwc[g] = gwn[g]; if (qb < 3) gwn[g] = *(const u32x2*)(proj + (size_t)(PN_RG + hd) * PST + (row0 + 32 * (qb + 1) + r) * 256 + 32 * w + 8 * g + 4 * h); }
#pragma unroll
            for (int kb = 0; kb <= qb; ++kb)
#pragma unroll
                for (int s2 = 0; s2 < 2; ++s2) { const bf16x8v pq = *(const LAS bf16x8v*)(Ps + (32 * qb + r) * RET_RS + (32 * kb + 16 * s2 + 8 * h) * 2); zi = MFMA32(Vf[2 * kb + s2], pq, zi); }
#pragma unroll
            for (int t = 0; t < 4; ++t)
#pragma unroll
                for (int s2 = 0; s2 < 2; ++s2) { const LAS unsigned char* qp = Qs + (32 * qb + r) * RET_RS + (32 * t + 16 * s2 + 4 * h) * 2;
                    const u32x2 lo = *(const LAS u32x2*)qp, hi = *(const LAS u32x2*)(qp + 16); u32x4 qq; qq.x = lo.x; qq.y = lo.y; qq.z = hi.x; qq.w = hi.y;
                    zc = MFMA32(Sp[t][s2], __builtin_bit_cast(bf16x8v, qq), zc); }
            const float xi = __builtin_amdgcn_exp2f(lg * (float)(32 * qb + r + 1));
            float ssq = 0.f;
#pragma unroll
            for (int i = 0; i < 16; ++i) { zi[i] = zi[i] + xi * zc[i]; ssq += zi[i] * zi[i]; }
            ssq += __shfl_xor(ssq, 32);
            if (h == 0) red[(32 * qb + r) * 8 + w] = ssq;
            lds_barrier();
            const f32x4 ra = *(const LAS f32x4*)(red + (32 * qb + r) * 8), rb = *(const LAS f32x4*)(red + (32 * qb + r) * 8 + 4);
            const float rstd = rsqrtf(((ra.x + ra.y) + (ra.z + ra.w) + (rb.x + rb.y) + (rb.z + rb.w)) * (1.f / 256.f) + RMS_EPS);
#pragma unroll
            for (int g = 0; g < 4; ++g) { const u32x2 gw = gwc[g];
                u32x2* op = (u32x2*)(proj + (size_t)(PN_RG + hd) * PST + (row0 + 32 * qb + r) * 256 + 32 * w + 8 * g + 4 * h);
                const float g0 = pg8::bf_lo(gw.x), g1 = pg8::bf_hi(gw.x), g2 = pg8::bf_lo(gw.y), g3 = pg8::bf_hi(gw.y);
                u32x2 ow; ow.x = cvtpk(g0 * pg8::sigmoidf_(g0) * zi[4 * g] * rstd, g1 * pg8::sigmoidf_(g1) * zi[4 * g + 1] * rstd); ow.y = cvtpk(g2 * pg8::sigmoidf_(g2) * zi[4 * g + 2] * rstd, g3 * pg8::sigmoidf_(g3) * zi[4 * g + 3] * rstd);
                *op = ow; }
        }
        { const float dec = __builtin_amdgcn_exp2f(lg * 128.f);
#pragma unroll
          for (int t = 0; t < 4; ++t) {
#pragma unroll
              for (int i = 0; i < 16; ++i) X[t][i] *= dec;
#pragma unroll
              for (int s = 0; s < 8; ++s) { const LAS unsigned char* kp = Ks + ktr + (16 * s) * RET_RS + (32 * t) * 2; X[t] = MFMA32(cat8(lds_tr(kp), lds_tr(kp + 4 * RET_RS)), Vf[s], X[t]); } } }
        lds_barrier();
    }
}

constexpr int SW_RS = 144;
__device__ __forceinline__ void swa_mfma(LAS unsigned char* lds, bf16* proj, const float* sinks, int unit0, int ustride, const int swave) {
    const int lane = lane_id_asm(), w = swave, tid = w * 64 + lane, r = lane & 31, h = lane >> 5;
    const int i16 = lane & 15, q4 = i16 >> 2, p4 = i16 & 3, blk = (lane >> 4) & 1;
    LAS unsigned char* Kb = lds; LAS unsigned char* Vb = lds + 256 * SW_RS;
    const int g = w >> 1, qh = w & 1;
    const int vtr = (4 * h + q4) * SW_RS + (16 * blk + 4 * p4) * 2;
    for (int u = unit0; u < NB * 4 * (SEQ / 128); u += ustride) {
        const int n = u & 15, hk = (u >> 4) & 3, b = u >> 6;
        const size_t rowb = (size_t)b * SEQ + (size_t)n * 128;
#pragma unroll
        for (int it = 0; it < 4; ++it) { const int pi = tid + 512 * it, row = pi >> 3, c8 = pi & 7;
            u32x4 kv = {0u, 0u, 0u, 0u}, vv = {0u, 0u, 0u, 0u};
            if (n > 0 || row >= 128) { const bf16* p = proj + (size_t)PN_SK * PST + (rowb + row - 128) * 256 + hk * 64 + c8 * 8; kv = *(const u32x4*)p; vv = *(const u32x4*)(p + PST); }
            *(LAS u32x4*)(Kb + row * SW_RS + c8 * 16) = kv; *(LAS u32x4*)(Vb + row * SW_RS + c8 * 16) = vv; }
        lds_barrier();
        const float sk = sinks[hk * 4 + g];
#pragma unroll 1
        for (int qg = 0; qg < 2; ++qg) { const int p0 = 64 * qh + 32 * qg, kb0 = 2 * qh + qg;
            bf16* qrow = proj + (size_t)(PN_SQ + hk) * PST + (rowb + p0 + r) * 256 + g * 64;
            bf16x8v qf[4];
#pragma unroll
            for (int s = 0; s < 4; ++s) qf[s] = *(const bf16x8v*)(qrow + 16 * s + 8 * h);
            f32x16 x[5];
#pragma unroll
            for (int j = 0; j < 5; ++j) {
#pragma unroll
                for (int i = 0; i < 16; ++i) x[j][i] = 0.f;
#pragma unroll
                for (int s = 0; s < 4; ++s) { const bf16x8v ka = *(const LAS bf16x8v*)(Kb + (32 * (kb0 + j) + r) * SW_RS + (16 * s + 8 * h) * 2); x[j] = MFMA32(ka, qf[s], x[j]); } }
            float m = -INFINITY;
#pragma unroll
            for (int j = 0; j < 5; ++j) { const float boff = ((n > 0) || (kb0 + j >= 4)) ? 0.f : -INFINITY;
#pragma unroll
                for (int i = 0; i < 16; ++i) { float a = x[j][i] * 0.125f + boff;
                    if (j == 0) a = (crow(i, h) > r) ? a : -INFINITY;
                    if (j == 4) a = (crow(i, h) <= r) ? a : -INFINITY;
                    x[j][i] = a; m = fmaxf(m, a); } }
            m = fmaxf(m, __shfl_xor(m, 32)); m = fmaxf(m, sk);
            float sum = 0.f;
#pragma unroll
            for (int j = 0; j < 5; ++j)
#pragma unroll
                for (int i = 0; i < 16; ++i) { const float e = __expf(x[j][i] - m); x[j][i] = e; sum += e; }
            sum += __shfl_xor(sum, 32);
            const float inv = 1.0f / (sum + __expf(sk - m));
            f32x16 o[2];
#pragma unroll
            for (int i = 0; i < 16; ++i) { o[0][i] = 0.f; o[1][i] = 0.f; }
#pragma unroll
            for (int j = 0; j < 5; ++j)
#pragma unroll
                for (int s = 0; s < 2; ++s) { const bf16x8v pb = pack_step(x[j], s);
#pragma unroll
                    for (int db = 0; db < 2; ++db) { const LAS unsigned char* vp = Vb + vtr + (32 * (kb0 + j) + 16 * s) * SW_RS + (32 * db) * 2;
                        o[db] = MFMA32(cat8(lds_tr(vp), lds_tr(vp + 8 * SW_RS)), pb, o[db]); } }
#pragma unroll
            for (int db = 0; db < 2; ++db)
#pragma unroll
                for (int gq = 0; gq < 4; ++gq) { u32x2 wv; wv.x = cvtpk(o[db][4 * gq] * inv, o[db][4 * gq + 1] * inv); wv.y = cvtpk(o[db][4 * gq + 2] * inv, o[db][4 * gq + 3] * inv);
                    *(u32x2*)(qrow + 32 * db + 8 * gq + 4 * h) = wv; }
        }
        lds_barrier();
    }
}

__device__ __forceinline__ void p4n_rows(const Args& a, int G, const int swave) {
    const int lane = lane_id_asm(), wave = swave; const int gw = blockIdx.x * NWAVES + wave, NGW = G * NWAVES;
    bf16* H = (bf16*)(a.ws + WS_H); float* rstd1 = (float*)(a.ws + WS_RSTD1);
    for (int m0 = gw; m0 < MTOK; m0 += 2 * NGW) {
        f32x4 v[2][8], xv[2][8];
#pragma unroll
        for (int rr = 0; rr < 2; ++rr) { const int m = (m0 + rr * NGW < MTOK) ? m0 + rr * NGW : m0;
            const u32x2* yb = (const u32x2*)((const bf16*)(a.ws + WS_Y1) + (size_t)m * 256) + lane; const f32x4* xr = (const f32x4*)(a.x + (size_t)m * DM) + lane;
#pragma unroll
            for (int j = 0; j < 8; ++j) { const u32x2 yw = __builtin_nontemporal_load(yb + (PST / 4) * j); v[rr][j] = (f32x4){pg8::bf_lo(yw.x), pg8::bf_hi(yw.x), pg8::bf_lo(yw.y), pg8::bf_hi(yw.y)}; xv[rr][j] = __builtin_nontemporal_load(xr + 64 * j); } }
#pragma unroll
        for (int rr = 0; rr < 2; ++rr) { const int m = m0 + rr * NGW; if (m >= MTOK) break;
            float s = 0.f;
#pragma unroll
            for (int j = 0; j < 8; ++j) s += (v[rr][j].x * v[rr][j].x + v[rr][j].y * v[rr][j].y) + (v[rr][j].z * v[rr][j].z + v[rr][j].w * v[rr][j].w);
            const float rstd = rsqrtf(wave_sum(s) * (1.f / DM) + RMS_EPS); float s2 = 0.f;
            if (lane == 0) rstd1[m] = rstd;
#pragma unroll
            for (int j = 0; j < 8; ++j) { const f32x4 gv = ((const f32x4*)a.g_post_mix)[lane + 64 * j]; const f32x4 t = xv[rr][j] + v[rr][j] * rstd * gv; v[rr][j] = t;
                s2 += (t.x * t.x + t.y * t.y) + (t.z * t.z + t.w * t.w); }
            const float rstd2 = rsqrtf(wave_sum(s2) * (1.f / DM) + RMS_EPS);
            u32x2* o8 = (u32x2*)(H + (size_t)m * DM) + lane;
#pragma unroll
            for (int j = 0; j < 8; ++j) { const f32x4 gv = ((const f32x4*)a.g_pre_ffn)[lane + 64 * j]; const f32x4 t = v[rr][j]; u32x2 w; w.x = pk2(t.x * rstd2 * gv.x, t.y * rstd2 * gv.y); w.y = pk2(t.z * rstd2 * gv.z, t.w * rstd2 * gv.w); o8[64 * j] = w; } }
    }
}
__device__ __forceinline__ void p6n_rows(const Args& a, int G, const int swave) {
    const int lane = lane_id_asm(), wave = swave; const int gw = blockIdx.x * NWAVES + wave, NGW = G * NWAVES;
    const bf16* Y2 = (const bf16*)(a.ws + WS_Y2); const bf16* Y1 = (const bf16*)(a.ws + WS_Y1); const float* rstd1 = (const float*)(a.ws + WS_RSTD1);
    for (int m = gw; m < MTOK; m += NGW) {
        f32x4 v[8], y1v[8], xv[8];
        const u32x2* yb = (const u32x2*)(Y2 + (size_t)m * 256) + lane; const u32x2* y1b = (const u32x2*)(Y1 + (size_t)m * 256) + lane; const f32x4* xr = (const f32x4*)(a.x + (size_t)m * DM) + lane;
        const float r1 = rstd1[m];
#pragma unroll
        for (int j = 0; j < 8; ++j) { const u32x2 yw = __builtin_nontemporal_load(yb + (PST / 4) * j), zw = __builtin_nontemporal_load(y1b + (PST / 4) * j);
            v[j] = (f32x4){pg8::bf_lo(yw.x), pg8::bf_hi(yw.x), pg8::bf_lo(yw.y), pg8::bf_hi(yw.y)}; y1v[j] = (f32x4){pg8::bf_lo(zw.x), pg8::bf_hi(zw.x), pg8::bf_lo(zw.y), pg8::bf_hi(zw.y)}; xv[j] = __builtin_nontemporal_load(xr + 64 * j); }
        f32x4* orow = (f32x4*)(a.out + (size_t)m * DM) + lane; float s = 0.f;
#pragma unroll
        for (int j = 0; j < 8; ++j) s += (v[j].x * v[j].x + v[j].y * v[j].y) + (v[j].z * v[j].z + v[j].w * v[j].w);
        const float rstd = rsqrtf(wave_sum(s) * (1.f / DM) + RMS_EPS);
#pragma unroll
        for (int j = 0; j < 8; ++j) { const f32x4 g1 = ((const f32x4*)a.g_post_mix)[lane + 64 * j], g2 = ((const f32x4*)a.g_post_ffn)[lane + 64 * j];
            const f32x4 x1 = xv[j] + y1v[j] * r1 * g1; __builtin_nontemporal_store(x1 + v[j] * rstd * g2, orow + 64 * j); }
    }
}
__device__ __forceinline__ void p5f_fixup(const Args& a, int G, const int swave) {
    const int tid = swave * 64 + lane_id_asm();
    bf16* Gp = (bf16*)(a.ws + WS_PROJ); const bf16* edge = (const bf16*)(a.ws + WS_EDGE);
    constexpr int NT = (MTOK / 64) * 44 * 16;
    for (int task = blockIdx.x * NTHR + tid; task < NT; task += G * NTHR) {
        const int pc = task & 15, pn = (task >> 4) % 44, Gi = task / (16 * 44); const int ct = pc * 8, C = pn * 128 + ct;
        float wv[3][8], wg[3][8], bv[8], bg[8];
#pragma unroll
        for (int k = 0; k < 3; ++k)
#pragma unroll
            for (int e = 0; e < 8; ++e) { wv[k][e] = a.conv_w[k * FF2 + C + e]; wg[k][e] = a.conv_w[k * FF2 + FF + C + e]; }
#pragma unroll
        for (int e = 0; e < 8; ++e) { bv[e] = a.conv_b[C + e]; bg[e] = a.conv_b[FF + C + e]; }
        float pv2[8], pv1[8], pg2[8], pg1[8], cv0[8], cg0[8], cv1[8], cg1[8];
        if ((Gi & 31) == 0) {
#pragma unroll
            for (int e = 0; e < 8; ++e) { pv2[e] = 0.f; pv1[e] = 0.f; pg2[e] = 0.f; pg1[e] = 0.f; }
        } else { const bf16* ep = edge + ((size_t)((Gi - 1) * 4 + 2) * 44 + pn) * 256 + ct;
            unpack8(*(const u32x4*)ep, pv2); unpack8(*(const u32x4*)(ep + 128), pg2); unpack8(*(const u32x4*)(ep + 44 * 256), pv1); unpack8(*(const u32x4*)(ep + 44 * 256 + 128), pg1); }
        { const bf16* ep = edge + ((size_t)(Gi * 4) * 44 + pn) * 256 + ct;
            unpack8(*(const u32x4*)ep, cv0); unpack8(*(const u32x4*)(ep + 128), cg0); unpack8(*(const u32x4*)(ep + 44 * 256), cv1); unpack8(*(const u32x4*)(ep + 44 * 256 + 128), cg1); }
        float o0[8], o1[8];
#pragma unroll
        for (int e = 0; e < 8; ++e) {
            const float yv0 = bv[e] + wv[0][e] * pv2[e] + wv[1][e] * pv1[e] + wv[2][e] * cv0[e], yg0 = bg[e] + wg[0][e] * pg2[e] + wg[1][e] * pg1[e] + wg[2][e] * cg0[e];
            const float yv1 = bv[e] + wv[0][e] * pv1[e] + wv[1][e] * cv0[e] + wv[2][e] * cv1[e], yg1 = bg[e] + wg[0][e] * pg1[e] + wg[1][e] * cg0[e] + wg[2][e] * cg1[e];
            o0[e] = pg8::gelu_tanh_f(yg0) * yv0; o1[e] = pg8::gelu_tanh_f(yg1) * yv1; }
        bf16* gp = Gp + (size_t)(pn >> 1) * PST + (size_t)(Gi * 64) * 256 + (pn & 1) * 128 + ct;
        u32x4 w; w.x = pk2(o0[0], o0[1]); w.y = pk2(o0[2], o0[3]); w.z = pk2(o0[4], o0[5]); w.w = pk2(o0[6], o0[7]); *(u32x4*)gp = w;
        w.x = pk2(o1[0], o1[1]); w.y = pk2(o1[2], o1[3]); w.z = pk2(o1[4], o1[5]); w.w = pk2(o1[6], o1[7]); *(u32x4*)(gp + 256) = w;
    }
}

#define XB_TMO      128
#define XB_XCNT(j)  (256  + 64 * (j))
#define XB_XSUB(j)  (1280 + 64 * (j))
#define XB_XGEN(j)  (2304 + 64 * (j))
#define XB_TOP      3328
#define XB_TOPGEN   3392
#define XCD_BAR_WORDS 3456
#define XB_SPIN_CAP (1u << 18)

__device__ __forceinline__ unsigned xb_ld(unsigned* p)              { return __hip_atomic_load(p, __ATOMIC_RELAXED, __HIP_MEMORY_SCOPE_AGENT); }
__device__ __forceinline__ unsigned xb_add(unsigned* p, unsigned v) { return __hip_atomic_fetch_add(p, v, __ATOMIC_RELAXED, __HIP_MEMORY_SCOPE_AGENT); }
__device__ __forceinline__ unsigned xb_xcc_id() { return (unsigned)__builtin_amdgcn_s_getreg((3 << 11) | 20) & 0xFu; }
#define XB_SPIN(cond, bar) do { unsigned _sp = 0; while (cond) { __builtin_amdgcn_s_sleep(1); \
    if ((++_sp & 255u) == 0u) { if (xb_ld(&(bar)[XB_TMO])) break; if (_sp > XB_SPIN_CAP) { atomicAdd(&(bar)[XB_TMO], 1u); break; } } } } while (0)

struct XcdBarrier {
    unsigned* bar; unsigned x;
    volatile LAS unsigned* st;
};

__device__ __forceinline__ XcdBarrier xcd_barrier_post(unsigned* bar, volatile LAS unsigned* st, const int swave) {
    XcdBarrier b; b.bar = bar; b.x = xb_xcc_id(); b.st = st;
    if (swave == 0 && lane_id_asm() == 0) (void)xb_add(&bar[XB_XCNT(b.x)], 1u);
    return b;
}
__device__ __forceinline__ void xcd_barrier_complete(unsigned* bar, unsigned x, unsigned& nloc, unsigned& nx) {
    const unsigned G = gridDim.x * gridDim.y * gridDim.z;
    unsigned sum, cnt, mine, sp = 0u;
    for (;;) {
        sum = 0u; cnt = 0u; mine = 0u;
#pragma unroll
        for (unsigned j = 0; j < 16; ++j) { const unsigned c = xb_ld(&bar[XB_XCNT(j)]); sum += c; cnt += (c > 0u) ? 1u : 0u; mine = (j == x) ? c : mine; }
        if (sum == G) break;
        __builtin_amdgcn_s_sleep(1);
        if ((++sp & 255u) == 0u) { if (xb_ld(&bar[XB_TMO])) break; if (sp > XB_SPIN_CAP) { atomicAdd(&bar[XB_TMO], 1u); break; } }
    }
    nloc = mine > 0u ? mine : 1u; nx = cnt > 0u ? cnt : 1u;
}

__device__ __forceinline__ void xcd_barrier(const XcdBarrier& b, const int swave) {
    asm volatile("s_waitcnt vmcnt(0)" ::: "memory");
    __syncthreads();
    if (swave == 0 && lane_id_asm() == 0) {
        unsigned* bar = b.bar;
        __builtin_amdgcn_s_waitcnt(0);
        unsigned nloc = b.st[0], nx = b.st[1];
        if (nloc == 0u) { xcd_barrier_complete(bar, b.x, nloc, nx); b.st[0] = nloc; b.st[1] = nx; }
        const unsigned old = xb_add(&bar[XB_XSUB(b.x)], 1u);
        const unsigned gen = old / nloc;
        if (old + 1u == (gen + 1u) * nloc) {
            __builtin_amdgcn_fence(__ATOMIC_RELEASE, "agent");
            asm volatile("s_waitcnt vmcnt(0)" ::: "memory");
            const unsigned og = xb_add(&bar[XB_TOP], 1u);
            const unsigned tg = og / nx;
            if (og + 1u == (tg + 1u) * nx) xb_add(&bar[XB_TOPGEN], 1u);
            else XB_SPIN(xb_ld(&bar[XB_TOPGEN]) == tg, bar);
            __builtin_amdgcn_fence(__ATOMIC_ACQUIRE, "agent");
            xb_add(&bar[XB_XGEN(b.x)], 1u);
            asm volatile("s_waitcnt vmcnt(0)" ::: "memory");
        } else {
            XB_SPIN(xb_ld(&bar[XB_XGEN(b.x)]) == gen, bar);
            __builtin_amdgcn_fence(__ATOMIC_ACQUIRE, "agent");
            asm volatile("s_waitcnt vmcnt(0)" ::: "memory");
        }
    }
    __syncthreads();
}

__global__ void __launch_bounds__(NTHR, 2) fwd_megakernel(Args a) {
    extern __shared__ __attribute__((aligned(16))) unsigned char lds_raw[];
    LAS unsigned char* lds = (LAS unsigned char*)lds_raw;
    cg::grid_group grid = cg::this_grid();
    const int G = gridDim.x;
    unsigned char* ws = a.ws;
    const int swave = __builtin_amdgcn_readfirstlane(threadIdx.x >> 6);
    volatile LAS unsigned* bst = (volatile LAS unsigned*)(lds + LDS_BYTES - 16);
    if (threadIdx.x < 4) bst[threadIdx.x] = 0u;
    __syncthreads();
    const XcdBarrier bar = xcd_barrier_post((unsigned*)(ws + WS_CTL), bst, swave);
    bf16* H = (bf16*)(ws + WS_H); bf16* PROJ = (bf16*)(ws + WS_PROJ);

    p0_prologue(a, lds, G, swave);
    if (a.ws == nullptr) grid.sync();
    xcd_barrier(bar, swave);
    { pg8::Gemm g{H, (const bf16*)(ws + WS_WIN), MTOK, INW, DM, DM, 512}; pg8::StaticOrder S; S.init(MTOK, INW, G, (int)blockIdx.x);
      pg8::EpiBf16<false> E{PROJ, 256, PST, nullptr, 0};
      pg8::gemm_phase<pg8::EpiBf16<false>, pg8::StaticOrder, true, true>(lds, g, S, E, swave); }
    xcd_barrier(bar, swave);
    { const float* rc = (const float*)(ws + WS_ROPE); const float* rs = rc + SEQ * 64;
      if (blockIdx.x < 128 || G < 256) for (int u = blockIdx.x; u < 128; u += G) ret_mfma(lds, PROJ, rc, rs, u >> 3, u & 7, swave);
      const int su0 = (G >= 256) ? (int)blockIdx.x - 128 : (int)blockIdx.x, sst = (G >= 256) ? G - 128 : G;
      if (su0 >= 0) swa_mfma(lds, PROJ, a.sinks, su0, sst, swave); }
    xcd_barrier(bar, swave);
    { pg8::Gemm g{PROJ + (size_t)PN_RG * PST, (const bf16*)(ws + WS_WRO), MTOK, DM, 3072, 256, PST * 2}; pg8::StaticOrder S; S.init(MTOK, DM, G, (int)blockIdx.x);
      pg8::EpiGateOut E{PROJ + (size_t)PN_GS * PST, H, PST};
      pg8::MidGate mid{32, PROJ + (size_t)PN_GR * PST, PROJ + (size_t)PN_GS * PST, PST};
      pg8::gemm_phase<pg8::EpiGateOut, pg8::StaticOrder, true, true, pg8::MidGate>(lds, g, S, E, swave, mid); }
    xcd_barrier(bar, swave);
    { pg8::Gemm g{H, (const bf16*)(ws + WS_WOUT), MTOK, DM, DM, 256, PST * 2}; pg8::StaticOrder S; S.init(MTOK, DM, G, (int)blockIdx.x);
      pg8::EpiBf16<false> E{(bf16*)(ws + WS_Y1), 256, PST, nullptr, 0};
      pg8::gemm_phase<pg8::EpiBf16<false>, pg8::StaticOrder, true, true>(lds, g, S, E, swave); }
    xcd_barrier(bar, swave);
    p4n_rows(a, G, swave);
    xcd_barrier(bar, swave);
    { pg8::Gemm g{H, (const bf16*)(ws + WS_WUP), MTOK, FF2, DM, DM, 512}; pg8::StaticOrder S; S.init(MTOK, FF2, G, (int)blockIdx.x);
      pg8::EpiConv E{PROJ, PST, a.conv_w, a.conv_b, (bf16*)(ws + WS_EDGE), FF};
      pg8::gemm_phase<pg8::EpiConv, pg8::StaticOrder, true, true>(lds, g, S, E, swave); }
    xcd_barrier(bar, swave);
    p5f_fixup(a, G, swave);
    xcd_barrier(bar, swave);
    { pg8::Gemm g{PROJ, (const bf16*)(ws + WS_WDN), MTOK, DM, FF, 256, PST * 2}; pg8::StaticOrder S; S.init(MTOK, DM, G, (int)blockIdx.x);
      pg8::EpiBf16<false> E{(bf16*)(ws + WS_Y2), 256, PST, nullptr, 0};
      pg8::gemm_phase<pg8::EpiBf16<false>, pg8::StaticOrder, true, true>(lds, g, S, E, swave); }
    xcd_barrier(bar, swave);
    p6n_rows(a, G, swave);
}

extern "C" void kernel_launch(void* const* d_in, const int* in_sizes, int n_in, void* d_out, int out_size, void* d_ws, size_t ws_size, hipStream_t stream) {
    static int grid = 0;
    if (grid == 0) {
        if (n_in != 14 || ws_size < WS_END) { fprintf(stderr, "kernel_launch: unexpected n_in %d / ws_size %zu (need %zu)\n", n_in, ws_size, (size_t)WS_END); grid = -1; return; }
        int dev = 0, cus = 0, per_cu = 0;
        hipGetDevice(&dev); hipDeviceGetAttribute(&cus, hipDeviceAttributeMultiprocessorCount, dev);
        if (hipFuncSetAttribute((const void*)fwd_megakernel, hipFuncAttributeMaxDynamicSharedMemorySize, LDS_BYTES) != hipSuccess) { fprintf(stderr, "kernel_launch: hipFuncSetAttribute failed\n"); grid = -1; return; }
        if (hipOccupancyMaxActiveBlocksPerMultiprocessor(&per_cu, (const void*)fwd_megakernel, NTHR, LDS_BYTES) != hipSuccess || per_cu < 1) { fprintf(stderr, "kernel_launch: occupancy query says %d\n", per_cu); per_cu = 1; }
        (void)hipGetLastError();
        grid = cus * per_cu;
        fprintf(stderr, "kernel_launch: grid %d (cus %d x %d)\n", grid, cus, per_cu);
    }
    if (grid < 0) return;
    if (hipMemsetAsync((char*)d_ws + WS_CTL, 0, WS_CTL_BYTES, stream) != hipSuccess) { fprintf(stderr, "kernel_launch: memset failed\n"); return; }
    Args a{};
    a.x = (const float*)d_in[0]; a.g_pre_mix = (const float*)d_in[1]; a.w_in = (const float*)d_in[2]; a.w_ret_o = (const float*)d_in[3]; a.w_swa_o = (const float*)d_in[4];
    a.w_out = (const float*)d_in[5]; a.sinks = (const float*)d_in[6]; a.g_post_mix = (const float*)d_in[7]; a.g_pre_ffn = (const float*)d_in[8]; a.w_up = (const float*)d_in[9];
    a.conv_w = (const float*)d_in[10]; a.conv_b = (const float*)d_in[11]; a.w_down = (const float*)d_in[12]; a.g_post_ffn = (const float*)d_in[13];
    a.out = (float*)d_out; a.ws = (unsigned char*)d_ws;
    void* args[] = {&a};
    hipError_t e = hipLaunchCooperativeKernel((const void*)fwd_megakernel, dim3(grid), dim3(NTHR), args, LDS_BYTES, stream);
    if (e != hipSuccess) fprintf(stderr, "cooperative launch failed: %s (grid %d)\n", hipGetErrorString(e), grid);
}
```

```cpp
#include <hip/hip_runtime.h>
#include <hip/hip_cooperative_groups.h>
#include <cstdio>
#include <cstdint>
namespace cg = cooperative_groups;

__device__ __forceinline__ int lane_id_asm() { int l; asm volatile("v_mbcnt_lo_u32_b32 %0, -1, 0\n\tv_mbcnt_hi_u32_b32 %0, -1, %0" : "=v"(l)); return l; }
namespace pg8 {
#define PG8_LAS __attribute__((address_space(3)))
typedef unsigned short bf16_t;
typedef short bf16x8 __attribute__((ext_vector_type(8)));
typedef float f32x4 __attribute__((ext_vector_type(4)));
typedef float f32x2 __attribute__((ext_vector_type(2)));
typedef unsigned u32x4 __attribute__((ext_vector_type(4)));
typedef unsigned u32x2 __attribute__((ext_vector_type(2)));
constexpr int BM = 256, BK = 64, HALF = 128, HTB = HALF * BK * 2  , STAGE_BYTES = 8 * HTB, NXCD = 8, WGM = 8;

__host__ __device__ __forceinline__ int lds_byte(int r, int c) { const int st = (r >> 4) * 2 + (c >> 5), rr = r & 15, cc = c & 31, ob = rr * 64 + cc * 2; return st * 1024 + (ob ^ (((ob >> 9) & 1) << 5)); }
__host__ __device__ __forceinline__ void stage_rc(int b, int& R, int& C) { const int st = b / 1024, sb = b % 1024, swz = sb ^ (((sb >> 9) & 1) << 5); R = (st >> 1) * 16 + swz / 64; C = (st & 1) * 32 + (swz % 64) / 2; }
__host__ __device__ __forceinline__ int perm32(int rho) { const int n = rho >> 4, i = rho & 15; return 8 * (i >> 2) + 4 * n + (i & 3); }

struct Unit { int pm, pn; };
struct Gemm { const bf16_t* A; const bf16_t* Bt; int M, N, K, lda; size_t apst; };

struct StaticOrder {
    int nM, nN, nwg, G, c;
    __host__ __device__ void init(int M, int N, int G_, int c_) { nM = M / BM; nN = N / BM; nwg = nM * nN; G = G_; c = c_; }
    __host__ __device__ bool next(int i, Unit& u) const {
        const long L = (long)i * G + c; if (L >= nwg) return false;
        int wgid = (int)L; { const int q = nwg / NXCD, r = nwg % NXCD, xcd = wgid % NXCD, off = wgid / NXCD; wgid = (xcd < r ? xcd * (q + 1) : r * (q + 1) + (xcd - r) * q) + off; }
        const int nig = WGM * nN, gid = wgid / nig, fm = gid * WGM, gsz = (nM - fm) < WGM ? (nM - fm) : WGM;
        u.pm = fm + ((wgid % nig) % gsz); u.pn = (wgid % nig) / gsz; return true;
    }
    __device__ __forceinline__ void a_ready(const Unit&) const {}
    __device__ __forceinline__ void done(const Unit&) const {}
};

__device__ __forceinline__ unsigned cvt_pk_bf16(float lo, float hi) { unsigned r; asm volatile("v_cvt_pk_bf16_f32 %0, %1, %2" : "=v"(r) : "v"(lo), "v"(hi)); return r; }
__device__ __forceinline__ float bf_lo(unsigned w) { return __uint_as_float(w << 16); }
__device__ __forceinline__ float bf_hi(unsigned w) { return __uint_as_float(w & 0xffff0000u); }
__device__ __forceinline__ float gclamp(float x) { return fminf(fmaxf(x, -30.f), 30.f); }
__device__ __forceinline__ float sigmoidf_(float x) { return __builtin_amdgcn_rcpf(1.0f + __expf(-x)); }

template <bool HALO> struct EpiBf16 {
    static constexpr bool PERM = true, AFTER_DRAIN = false;
    bf16_t* O; int ldc; size_t pst; bf16_t* halo; int ldh;
    __device__ __forceinline__ void operator()(const f32x4 (&acc)[2][2][4][2], const Unit& u, int wr, int wc, int fr, int fq) const {
        const int row0 = u.pm * BM + wr * 64 + fr; const int colt = wc * 32 + 8 * fq; const int col0 = u.pn * BM + colt;
#pragma unroll
        for (int ai = 0; ai < 2; ++ai)
#pragma unroll
            for (int m = 0; m < 4; ++m) { bf16_t* rowp = O + (size_t)u.pn * pst + (size_t)(row0 + ai * HALF + m * 16) * ldc + colt;
#pragma unroll
                for (int bj = 0; bj < 2; ++bj) { const f32x4 v0 = acc[ai][bj][m][0], v1 = acc[ai][bj][m][1];
                    u32x4 w; w.x = cvt_pk_bf16(v0[0], v0[1]); w.y = cvt_pk_bf16(v0[2], v0[3]); w.z = cvt_pk_bf16(v1[0], v1[1]); w.w = cvt_pk_bf16(v1[2], v1[3]);
                    *(u32x4*)(rowp + bj * HALF) = w;
                    if (HALO) { if (m == 3 && wr == 1 && fr >= 14) *(u32x4*)(halo + (size_t)((u.pm * 2 + ai) * 2 + (fr - 14)) * ldh + col0 + bj * HALF) = w; } } }
    }
};
__device__ __forceinline__ float dpp_ror1(float x) { return __int_as_float(__builtin_amdgcn_mov_dpp(__float_as_int(x), 0x121, 0xf, 0xf, true)); }
__device__ __forceinline__ float dpp_ror2(float x) { return __int_as_float(__builtin_amdgcn_mov_dpp(__float_as_int(x), 0x122, 0xf, 0xf, true)); }
__device__ __forceinline__ float dpp_shr1(float old, float x) { return __int_as_float(__builtin_amdgcn_update_dpp(__float_as_int(old), __float_as_int(x), 0x111, 0xf, 0xf, false)); }
__device__ __forceinline__ float dpp_shr2(float old, float x) { return __int_as_float(__builtin_amdgcn_update_dpp(__float_as_int(old), __float_as_int(x), 0x112, 0xf, 0xf, false)); }
__device__ __forceinline__ float conv3(float b, float w0, float p2, float w1, float p1, float w2, float u) {
    float r; asm("v_fma_f32 %0, %1, %2, %3" : "=v"(r) : "v"(w0), "v"(p2), "v"(b)); asm("v_fmac_f32 %0, %1, %2" : "+v"(r) : "v"(w1), "v"(p1)); asm("v_fmac_f32 %0, %1, %2" : "+v"(r) : "v"(w2), "v"(u)); return r; }
__device__ __forceinline__ float gelu_tanh_f(float x) { const float z = x * (0.7978845608028654f + 0.035677408136300125f * x * x); return x * __builtin_amdgcn_rcpf(1.0f + __builtin_amdgcn_exp2f(-2.8853900817779268f * z)); }
struct EpiConv {
    static constexpr bool PERM = true, AFTER_DRAIN = false;
    bf16_t* Gp; size_t pst; const float* cw; const float* cb; bf16_t* edge; int ff;
    __device__ __forceinline__ void operator()(const f32x4 (&acc)[2][2][4][2], const Unit& u, int wr, int wc, int fr, int fq) const {
        const int ct = wc * 32 + 8 * fq;
        const int C = u.pn * 128 + ct;
#pragma unroll
        for (int ai = 0; ai < 2; ++ai) { const int Gi = u.pm * 4 + ai * 2 + wr;
#pragma unroll
            for (int which = 0; which < 2; ++which) { const int m = which ? 3 : 0; const bool on = which ? (fr >= 14) : (fr < 2); const int slot = which ? fr - 12 : fr;
                if (on) {
#pragma unroll
                    for (int bj = 0; bj < 2; ++bj) { const f32x4 v0 = acc[ai][bj][m][0], v1 = acc[ai][bj][m][1];
                        u32x4 w; w.x = cvt_pk_bf16(v0[0], v0[1]); w.y = cvt_pk_bf16(v0[2], v0[3]); w.z = cvt_pk_bf16(v1[0], v1[1]); w.w = cvt_pk_bf16(v1[2], v1[3]);
                        *(u32x4*)(edge + ((size_t)(Gi * 4 + slot) * 44 + u.pn) * 256 + bj * 128 + ct) = w; } } } }
        float c[2][2][4][8];
#pragma unroll
        for (int ai = 0; ai < 2; ++ai)
#pragma unroll
            for (int bj = 0; bj < 2; ++bj)
#pragma unroll
                for (int m = 0; m < 4; ++m)
#pragma unroll
                    for (int e = 0; e < 8; ++e) c[ai][bj][m][e] = acc[ai][bj][m][e >> 2][e & 3];
#pragma unroll
        for (int bj = 0; bj < 2; ++bj) { const int Cg = C + bj * ff;
            const f32x4 w0a = *(const f32x4*)(cw + Cg), w0b = *(const f32x4*)(cw + Cg + 4), w1a = *(const f32x4*)(cw + 2 * ff + Cg), w1b = *(const f32x4*)(cw + 2 * ff + Cg + 4);
            const f32x4 w2a = *(const f32x4*)(cw + 4 * ff + Cg), w2b = *(const f32x4*)(cw + 4 * ff + Cg + 4), ba = *(const f32x4*)(cb + Cg), bb = *(const f32x4*)(cb + Cg + 4);
#pragma unroll
            for (int e = 0; e < 8; ++e) { const float w0 = (e >> 2) ? w0b[e & 3] : w0a[e & 3], w1 = (e >> 2) ? w1b[e & 3] : w1a[e & 3], w2 = (e >> 2) ? w2b[e & 3] : w2a[e & 3], bs = (e >> 2) ? bb[e & 3] : ba[e & 3];
#pragma unroll
                for (int ai = 0; ai < 2; ++ai) {
                    const float u0 = c[ai][bj][0][e], u1 = c[ai][bj][1][e], u2 = c[ai][bj][2][e], u3 = c[ai][bj][3][e];
                    const float p13 = dpp_shr1(dpp_ror1(u2), u3), p12 = dpp_shr1(dpp_ror1(u1), u2), p11 = dpp_shr1(dpp_ror1(u0), u1), p10 = dpp_shr1(0.f, u0);
                    const float p23 = dpp_shr2(dpp_ror2(u2), u3), p22 = dpp_shr2(dpp_ror2(u1), u2), p21 = dpp_shr2(dpp_ror2(u0), u1), p20 = dpp_shr2(0.f, u0);
                    c[ai][bj][3][e] = conv3(bs, w0, p23, w1, p13, w2, u3);
                    c[ai][bj][2][e] = conv3(bs, w0, p22, w1, p12, w2, u2);
                    c[ai][bj][1][e] = conv3(bs, w0, p21, w1, p11, w2, u1);
                    c[ai][bj][0][e] = conv3(bs, w0, p20, w1, p10, w2, u0); } } }
        const int row0 = u.pm * BM + wr * 64 + fr;
#pragma unroll
        for (int ai = 0; ai < 2; ++ai)
#pragma unroll
            for (int m = 0; m < 4; ++m) { float o[8];
#pragma unroll
                for (int e = 0; e < 8; e += 2) { const f32x2 x = {c[ai][1][m][e], c[ai][1][m][e + 1]}, vv = {c[ai][0][m][e], c[ai][0][m][e + 1]};
                    const f32x2 arg = x * ((x * x) * (-0.10294323f) + (-2.30220819f)); f32x2 d; d.x = 1.0f + __builtin_amdgcn_exp2f(arg.x); d.y = 1.0f + __builtin_amdgcn_exp2f(arg.y);
                    f32x2 r; r.x = __builtin_amdgcn_rcpf(d.x); r.y = __builtin_amdgcn_rcpf(d.y); const f32x2 oo = (x * vv) * r; o[e] = oo.x; o[e + 1] = oo.y; }
                u32x4 w; w.x = cvt_pk_bf16(o[0], o[1]); w.y = cvt_pk_bf16(o[2], o[3]); w.z = cvt_pk_bf16(o[4], o[5]); w.w = cvt_pk_bf16(o[6], o[7]);
                if (m > 0 || fr >= 2) *(u32x4*)(Gp + (size_t)(u.pn >> 1) * pst + (size_t)(row0 + ai * HALF + m * 16) * 256 + (u.pn & 1) * 128 + ct) = w; }
    }
};

struct MidNone { static constexpr bool ON = false; int t_at; __device__ __forceinline__ void operator()(f32x4 (&)[2][2][4][2], const Unit&, int, int, int, int) const {} };
struct MidGate { static constexpr bool ON = true; int t_at; const bf16_t* Gr; const bf16_t* Gs; size_t pst;
    __device__ __forceinline__ void operator()(f32x4 (&acc)[2][2][4][2], const Unit& u, int wr, int wc, int fr_, int fq_) const {
        const int l = lane_id_asm(), fr = l & 15, fq = l >> 4;
        const int row0 = u.pm * BM + wr * 64 + fr; const int col0 = wc * 32 + 8 * fq; const size_t pb = (size_t)u.pn * pst;
#pragma unroll
        for (int ai = 0; ai < 2; ++ai)
#pragma unroll
            for (int m = 0; m < 4; ++m) { const size_t off = pb + (size_t)(row0 + ai * HALF + m * 16) * 256 + col0;
#pragma unroll
                for (int bj = 0; bj < 2; ++bj) { const u32x4 a = *(const u32x4*)(Gr + off + bj * HALF), b = *(const u32x4*)(Gs + off + bj * HALF);
                    f32x4 r0, r1;
                    r0[0] = (1.f + __expf(-gclamp(bf_lo(b.x)))) * __builtin_amdgcn_rcpf(1.f + __expf(-gclamp(bf_lo(a.x)))); r0[1] = (1.f + __expf(-gclamp(bf_hi(b.x)))) * __builtin_amdgcn_rcpf(1.f + __expf(-gclamp(bf_hi(a.x))));
                    r0[2] = (1.f + __expf(-gclamp(bf_lo(b.y)))) * __builtin_amdgcn_rcpf(1.f + __expf(-gclamp(bf_lo(a.y)))); r0[3] = (1.f + __expf(-gclamp(bf_hi(b.y)))) * __builtin_amdgcn_rcpf(1.f + __expf(-gclamp(bf_hi(a.y))));
                    r1[0] = (1.f + __expf(-gclamp(bf_lo(b.z)))) * __builtin_amdgcn_rcpf(1.f + __expf(-gclamp(bf_lo(a.z)))); r1[1] = (1.f + __expf(-gclamp(bf_hi(b.z)))) * __builtin_amdgcn_rcpf(1.f + __expf(-gclamp(bf_hi(a.z))));
                    r1[2] = (1.f + __expf(-gclamp(bf_lo(b.w)))) * __builtin_amdgcn_rcpf(1.f + __expf(-gclamp(bf_lo(a.w)))); r1[3] = (1.f + __expf(-gclamp(bf_hi(b.w)))) * __builtin_amdgcn_rcpf(1.f + __expf(-gclamp(bf_hi(a.w))));
                    acc[ai][bj][m][0] *= r0; acc[ai][bj][m][1] *= r1; } }
    }
};
struct EpiGateOut {
    static constexpr bool PERM = true, AFTER_DRAIN = false;
    const bf16_t* G; bf16_t* O; size_t pst;
    __device__ __forceinline__ void operator()(const f32x4 (&acc)[2][2][4][2], const Unit& u, int wr, int wc, int fr, int fq) const {
        const int row0 = u.pm * BM + wr * 64 + fr; const int col0 = wc * 32 + 8 * fq; const size_t pb = (size_t)u.pn * pst;
#pragma unroll
        for (int ai = 0; ai < 2; ++ai)
#pragma unroll
            for (int m = 0; m < 4; ++m) { const size_t off = pb + (size_t)(row0 + ai * HALF + m * 16) * 256 + col0;
#pragma unroll
                for (int bj = 0; bj < 2; ++bj) { const u32x4 gw = *(const u32x4*)(G + off + bj * HALF);
                    f32x4 v0 = acc[ai][bj][m][0], v1 = acc[ai][bj][m][1];
                    v0[0] *= sigmoidf_(gclamp(bf_lo(gw.x))); v0[1] *= sigmoidf_(gclamp(bf_hi(gw.x))); v0[2] *= sigmoidf_(gclamp(bf_lo(gw.y))); v0[3] *= sigmoidf_(gclamp(bf_hi(gw.y)));
                    v1[0] *= sigmoidf_(gclamp(bf_lo(gw.z))); v1[1] *= sigmoidf_(gclamp(bf_hi(gw.z))); v1[2] *= sigmoidf_(gclamp(bf_lo(gw.w))); v1[3] *= sigmoidf_(gclamp(bf_hi(gw.w)));
                    u32x4 w; w.x = cvt_pk_bf16(v0[0], v0[1]); w.y = cvt_pk_bf16(v0[2], v0[3]); w.z = cvt_pk_bf16(v1[0], v1[1]); w.w = cvt_pk_bf16(v1[2], v1[3]);
                    *(u32x4*)(O + off + bj * HALF) = w; } }
    }
};

template <class Epi, class Sched, bool ALIGN_EPI = false, bool SP2 = false, class Mid = MidNone>
__device__ __forceinline__ void gemm_phase(PG8_LAS unsigned char* lds, const Gemm g, const Sched& S, const Epi& E, const int swave, const Mid mid = Mid{}) {
    const int lane = lane_id_asm(), wid = swave, tid = wid * 64 + lane, wr = wid >> 2, wc = wid & 3, fr = lane & 15, fq = lane >> 4;
    const int K = g.K, nt = K / BK;
    unsigned voffA[2], voffB[2];
#pragma unroll
    for (int i = 0; i < 2; ++i) { int R, C; stage_rc(tid * 16 + i * 8192, R, C); const int Rb = Epi::PERM ? ((R & ~31) + perm32(R & 31)) : R;
        voffA[i] = (unsigned)(R * g.lda + C) * 2u; voffB[i] = (unsigned)(Rb * K + C) * 2u; }
    const size_t kstep = (size_t)(BK * 2);
    const size_t hstepA = (size_t)HALF * g.lda * 2, hstepB = (size_t)HALF * K * 2;
    const size_t tstepA = 2 * hstepA, tstepB = 2 * hstepB;
    const unsigned ldsw = (unsigned)wid * 1024u;
    const int aoff = lds_byte(wr * 64 + fr, fq * 8), boff = lds_byte(wc * 32 + fr, fq * 8);
#define PG8_SA(b, h) (((b) * 2 + (h)) * HTB)
#define PG8_SB(b, h) ((4 + (b) * 2 + (h)) * HTB)
#define PG8_STAGE(bufoff, gbase, voff) do { _Pragma("unroll") for (int _i = 0; _i < 2; ++_i) \
        __builtin_amdgcn_global_load_lds((const unsigned*)((const char*)(gbase) + (voff)[_i]), (PG8_LAS unsigned*)(lds + (bufoff) + ldsw + _i * 8192), 16, 0, 0); } while (0)
#define PG8_LDA(dst, b, h) do { _Pragma("unroll") for (int m = 0; m < 4; ++m) _Pragma("unroll") for (int k = 0; k < 2; ++k) dst[m][k] = *(const PG8_LAS bf16x8*)(lds + PG8_SA(b, h) + aoff + m * 2048 + k * 1024); } while (0)
#define PG8_LDB(dst, b, h) do { _Pragma("unroll") for (int n = 0; n < 2; ++n) _Pragma("unroll") for (int k = 0; k < 2; ++k) dst[n][k] = *(const PG8_LAS bf16x8*)(lds + PG8_SB(b, h) + boff + n * 2048 + k * 1024); } while (0)
#define PG8_MMA(ai, bj, At, Bt) do { __builtin_amdgcn_s_setprio(1); _Pragma("unroll") for (int m = 0; m < 4; ++m) _Pragma("unroll") for (int n = 0; n < 2; ++n) _Pragma("unroll") for (int k = 0; k < 2; ++k) \
        acc[ai][bj][m][n] = __builtin_amdgcn_mfma_f32_16x16x32_bf16(Bt[n][k], At[m][k], acc[ai][bj][m][n], 0, 0, 0); __builtin_amdgcn_s_setprio(0); } while (0)
#define PG8_WAIT_V(n) asm volatile("s_waitcnt vmcnt(" #n ")" ::: "memory")
#define PG8_WAIT_L(n) asm volatile("s_waitcnt lgkmcnt(" #n ")" ::: "memory")
#define PG8_BAR __builtin_amdgcn_s_barrier()
#define PG8_SCHED __builtin_amdgcn_sched_barrier(0)
    Unit cur, nxt; int ui = 0;
    if (!S.next(0, cur)) return;
    f32x4 acc[2][2][4][2];
#pragma unroll
    for (int a = 0; a < 2; ++a)
#pragma unroll
        for (int b = 0; b < 2; ++b)
#pragma unroll
            for (int m = 0; m < 4; ++m)
#pragma unroll
                for (int n = 0; n < 2; ++n) acc[a][b][m][n] = (f32x4){0.f, 0.f, 0.f, 0.f};
    bf16x8 At[4][2], B0[2][2], B1[2][2];
    const char* cA = (const char*)g.A + (size_t)cur.pm * tstepA; const char* cB = (const char*)g.Bt + (size_t)cur.pn * tstepB;
    S.a_ready(cur);
    if constexpr (SP2) {
        PG8_STAGE(PG8_SB(0, 0), cB, voffB); PG8_STAGE(PG8_SB(0, 1), cB + hstepB, voffB); PG8_STAGE(PG8_SA(0, 0), cA, voffA); PG8_STAGE(PG8_SA(0, 1), cA + hstepA, voffA);
        if (wr == 1) PG8_BAR;
        PG8_WAIT_V(2); PG8_BAR;
        PG8_STAGE(PG8_SB(1, 0), cB + kstep, voffB); PG8_STAGE(PG8_SA(1, 0), cA + kstep, voffA); PG8_STAGE(PG8_SB(1, 1), cB + hstepB + kstep, voffB);
        PG8_WAIT_V(6); PG8_BAR;
    } else {
        PG8_STAGE(PG8_SB(0, 0), cB, voffB); PG8_STAGE(PG8_SA(0, 0), cA, voffA); PG8_STAGE(PG8_SB(0, 1), cB + hstepB, voffB); PG8_STAGE(PG8_SA(0, 1), cA + hstepA, voffA);
        if (wr == 1) PG8_BAR;
        PG8_WAIT_V(4); PG8_BAR;
        PG8_STAGE(PG8_SB(1, 0), cB + kstep, voffB); PG8_STAGE(PG8_SA(1, 0), cA + kstep, voffA); PG8_STAGE(PG8_SB(1, 1), cB + hstepB + kstep, voffB);
        PG8_WAIT_V(6); PG8_BAR;
    }
    for (;;) {
        const bool has_next = S.next(ui + 1, nxt);
        const char* nA = has_next ? (const char*)g.A + (size_t)nxt.pm * tstepA : cA; const char* nB = has_next ? (const char*)g.Bt + (size_t)nxt.pn * tstepB : cB;
        for (int t = 0; t < nt; t += 2) {
            const bool last = (t == nt - 2);
            const char* a1 = cA + (size_t)((t + 1) >> 2) * g.apst + (size_t)((t + 1) & 3) * kstep;
            const char* a2 = last ? nA : cA + (size_t)((t + 2) >> 2) * g.apst + (size_t)((t + 2) & 3) * kstep; const char* b2 = last ? nB : cB + (size_t)(t + 2) * kstep;
            const char* a3 = a2 + kstep; const char* b3 = b2 + kstep;
            if (last && has_next) S.a_ready(nxt);
            if constexpr (Mid::ON) { if (t == mid.t_at) mid(acc, cur, wr, wc, fr, fq); }
            if constexpr (SP2) {
            PG8_LDB(B0, 0, 0); PG8_LDB(B1, 0, 1); PG8_SCHED; PG8_LDA(At, 0, 0); PG8_STAGE(PG8_SA(1, 1), a1 + hstepA, voffA);
            PG8_WAIT_V(8); PG8_WAIT_L(0); PG8_BAR; PG8_MMA(0, 0, At, B0); PG8_MMA(0, 1, At, B1); PG8_BAR; PG8_SCHED;
            PG8_LDA(At, 0, 1); PG8_STAGE(PG8_SB(0, 0), b2, voffB); PG8_STAGE(PG8_SB(0, 1), b2 + hstepB, voffB); PG8_STAGE(PG8_SA(0, 0), a2, voffA);
            PG8_WAIT_V(8); PG8_WAIT_L(0); PG8_BAR; PG8_MMA(1, 0, At, B0); PG8_MMA(1, 1, At, B1); PG8_BAR; PG8_SCHED;
            PG8_LDB(B0, 1, 0); PG8_LDB(B1, 1, 1); PG8_SCHED; PG8_LDA(At, 1, 0); PG8_STAGE(PG8_SA(0, 1), a2 + hstepA, voffA);
            PG8_WAIT_V(8); PG8_WAIT_L(0); PG8_BAR; PG8_MMA(0, 0, At, B0); PG8_MMA(0, 1, At, B1); PG8_BAR; PG8_SCHED;
            PG8_LDA(At, 1, 1); PG8_STAGE(PG8_SB(1, 0), b3, voffB); PG8_STAGE(PG8_SB(1, 1), b3 + hstepB, voffB); PG8_STAGE(PG8_SA(1, 0), a3, voffA);
            PG8_WAIT_V(8); PG8_WAIT_L(0); PG8_BAR; PG8_MMA(1, 0, At, B0); PG8_MMA(1, 1, At, B1); PG8_BAR; PG8_SCHED;
            } else {
            PG8_LDB(B0, 0, 0); PG8_SCHED; PG8_LDA(At, 0, 0); PG8_STAGE(PG8_SA(1, 1), a1 + hstepA, voffA);
            PG8_WAIT_L(8); PG8_BAR; PG8_WAIT_L(0); PG8_MMA(0, 0, At, B0); PG8_BAR; PG8_SCHED;
            PG8_LDB(B1, 0, 1); PG8_STAGE(PG8_SB(0, 0), b2, voffB);
            PG8_BAR; PG8_WAIT_L(0); PG8_MMA(0, 1, At, B1); PG8_BAR;
            PG8_LDA(At, 0, 1); PG8_STAGE(PG8_SA(0, 0), a2, voffA);
            PG8_BAR; PG8_WAIT_L(0); PG8_MMA(1, 0, At, B0); PG8_BAR; PG8_SCHED;
            PG8_STAGE(PG8_SB(0, 1), b2 + hstepB, voffB);
            PG8_WAIT_V(6); PG8_BAR; PG8_MMA(1, 1, At, B1); PG8_BAR;
            PG8_LDB(B0, 1, 0); PG8_SCHED; PG8_LDA(At, 1, 0); PG8_STAGE(PG8_SA(0, 1), a2 + hstepA, voffA);
            PG8_WAIT_L(8); PG8_BAR; PG8_WAIT_L(0); PG8_MMA(0, 0, At, B0); PG8_BAR; PG8_SCHED;
            PG8_LDB(B1, 1, 1); PG8_STAGE(PG8_SB(1, 0), b3, voffB);
            PG8_BAR; PG8_WAIT_L(0); PG8_MMA(0, 1, At, B1); PG8_BAR;
            PG8_LDA(At, 1, 1); PG8_STAGE(PG8_SA(1, 0), a3, voffA);
            PG8_BAR; PG8_WAIT_L(0); PG8_MMA(1, 0, At, B0); PG8_BAR; PG8_SCHED;
            PG8_STAGE(PG8_SB(1, 1), b3 + hstepB, voffB);
            PG8_WAIT_V(6); PG8_BAR; PG8_MMA(1, 1, At, B1); PG8_BAR;
            }
        }
        if constexpr (ALIGN_EPI) { if (wr == 0) PG8_BAR; }
        if constexpr (!Epi::AFTER_DRAIN) { E(acc, cur, wr, wc, fr, fq); S.done(cur); }
        if (!has_next) break;
#pragma unroll
        for (int a = 0; a < 2; ++a)
#pragma unroll
            for (int b = 0; b < 2; ++b)
#pragma unroll
                for (int m = 0; m < 4; ++m)
#pragma unroll
                    for (int n = 0; n < 2; ++n) acc[a][b][m][n] = (f32x4){0.f, 0.f, 0.f, 0.f};
        cur = nxt; cA = nA; cB = nB; ++ui;
        if constexpr (ALIGN_EPI) { if (wr == 1) PG8_BAR; }
    }
    PG8_WAIT_V(0);
    if constexpr (!ALIGN_EPI) { if (wr == 0) PG8_BAR; }
    PG8_BAR;
    if constexpr (Epi::AFTER_DRAIN) { E.fused(acc, cur, wr, wc, fr, fq, lds, wid, lane); S.done(cur); }
#undef PG8_SA
#undef PG8_SB
#undef PG8_STAGE
#undef PG8_LDA
#undef PG8_LDB
#undef PG8_MMA
#undef PG8_WAIT_V
#undef PG8_WAIT_L
#undef PG8_BAR
#undef PG8_SCHED
}
}

constexpr int DM = 2048, SEQ = 2048, NB = 16, MTOK = NB * SEQ;
constexpr int INW = 11776, FF = 5632, FF2 = 11264;
constexpr int C_RQ = 0, C_RK = 1024, C_RV = 2048, C_RG = 4096, C_SQ = 6144, C_SK = 7168, C_SV = 7424, C_GR = 7680, C_GS = 9728;
constexpr float RMS_EPS = 1e-6f;
constexpr size_t PST = (size_t)MTOK * 256;
constexpr int PN_RQ = 0, PN_RK = 4, PN_RV = 8, PN_RG = 16, PN_SQ = 24, PN_SK = 28, PN_SV = 29, PN_GR = 30, PN_GS = 38, PN_UG = 22;
constexpr size_t MiB = (size_t)1 << 20;
constexpr size_t WS_CTL = 0, WS_CTL_BYTES = 16384;
constexpr size_t WS_WIN = 1 * MiB, WS_WRO = 47 * MiB  , WS_WOUT = 59 * MiB, WS_WUP = 67 * MiB;
constexpr size_t WS_H = 133 * MiB, WS_PROJ = 261 * MiB, WS_WDN = 997 * MiB, WS_ROPE = 1019 * MiB, WS_Y2 = 1 * MiB, WS_END = 1021 * MiB;
constexpr size_t WS_EDGE = WS_PROJ + 400 * MiB;
constexpr size_t WS_Y1 = WS_PROJ + 448 * MiB;
constexpr size_t WS_RSTD1 = 1020 * MiB;
constexpr int LDS_BYTES = 147456;
constexpr int NWAVES = 8, NTHR = 512;

typedef unsigned short bf16;
typedef float f32x4 __attribute__((ext_vector_type(4)));
typedef unsigned u32x4 __attribute__((ext_vector_type(4)));
typedef unsigned u32x2 __attribute__((ext_vector_type(2)));
#define LAS __attribute__((address_space(3)))
#define LDS_WAIT() asm volatile("s_waitcnt lgkmcnt(0)" ::: "memory")

__device__ __forceinline__ float bf2f(bf16 b) { return __uint_as_float(((unsigned)b) << 16); }
__device__ __forceinline__ unsigned f2bf(float f) { unsigned u = __float_as_uint(f); return (u + 0x7fffu + ((u >> 16) & 1u)) >> 16; }
__device__ __forceinline__ unsigned pk2(float lo, float hi) { typedef float f2_t __attribute__((ext_vector_type(2))); typedef __bf16 b2_t __attribute__((ext_vector_type(2))); f2_t v = {lo, hi}; b2_t b = __builtin_convertvector(v, b2_t); return __builtin_bit_cast(unsigned, b); }
__device__ __forceinline__ float wave_sum(float v) {
#pragma unroll
    for (int o = 1; o < 64; o <<= 1) v += __shfl_xor(v, o);
    return v;
}
__device__ __forceinline__ float wave_max(float v) {
#pragma unroll
    for (int o = 1; o < 64; o <<= 1) v = fmaxf(v, __shfl_xor(v, o));
    return v;
}

struct Args {
    const float *x, *g_pre_mix, *w_in, *w_ret_o, *w_swa_o, *w_out, *sinks, *g_post_mix, *g_pre_ffn, *w_up, *conv_w, *conv_b, *w_down, *g_post_ffn;
    float* out; unsigned char* ws;
};

template <bool UPPERM> __device__ __forceinline__ void p0_transpose_item(const float* W, int K, int N, bf16* WT, LAS float* scr, int item, int lane, int ldk = 0, int koff = 0) {
    const int nblk = N / 32, kb = item / nblk, nb = item % nblk, k0 = 64 * kb, n0 = 32 * nb;
    const int sn0 = UPPERM ? ((n0 >> 7) & 1) * FF + 128 * (n0 >> 8) + (n0 & 127) : n0;
#pragma unroll 8
    for (int i = 0; i < 32; ++i) { const int kk = 2 * i + (lane >> 5); scr[kk * 33 + (lane & 31)] = __builtin_nontemporal_load(W + (size_t)(k0 + kk) * N + sn0 + (lane & 31)); }
    LDS_WAIT();
    const int c = lane & 7;
#pragma unroll
    for (int j = 0; j < 4; ++j) { const int n = (lane >> 3) + 8 * j; const LAS float* s = scr + (8 * c) * 33 + n;
        u32x4 o; o.x = pk2(s[0 * 33], s[1 * 33]); o.y = pk2(s[2 * 33], s[3 * 33]); o.z = pk2(s[4 * 33], s[5 * 33]); o.w = pk2(s[6 * 33], s[7 * 33]);
        *(u32x4*)(WT + (size_t)(n0 + n) * (ldk ? ldk : K) + koff + k0 + 8 * c) = o; }
    LDS_WAIT();
}
__device__ __forceinline__ void rms_row_to_bf16(const float* xrow, const float* g, bf16* orow, int lane) {
    const f32x4* xr = (const f32x4*)xrow + lane; f32x4 v[8]; float s = 0.f;
#pragma unroll
    for (int j = 0; j < 8; ++j) { v[j] = __builtin_nontemporal_load(xr + 64 * j); s += (v[j].x * v[j].x + v[j].y * v[j].y) + (v[j].z * v[j].z + v[j].w * v[j].w); }
    const float rstd = rsqrtf(wave_sum(s) * (1.f / DM) + RMS_EPS);
    u32x2* o8 = (u32x2*)orow + lane;
#pragma unroll
    for (int j = 0; j < 8; ++j) { const f32x4 gv = ((const f32x4*)g)[lane + 64 * j]; u32x2 w; w.x = pk2(v[j].x * rstd * gv.x, v[j].y * rstd * gv.y); w.y = pk2(v[j].z * rstd * gv.z, v[j].w * rstd * gv.w); o8[64 * j] = w; }
}
__device__ __forceinline__ void p0_prologue(const Args& a, LAS unsigned char* lds, int G, const int swave) {
    const int lane = lane_id_asm(), wave = swave, tid = wave * 64 + lane;
    LAS float* scr = (LAS float*)(lds + wave * 16384);
    const int gw = blockIdx.x * NWAVES + wave, NGW = G * NWAVES;
    constexpr int I_IN = (DM / 64) * (INW / 32), I_RO = (DM / 64) * (DM / 32), I_SO = (1024 / 64) * (DM / 32), I_OUT = I_RO, I_UP = (DM / 64) * (FF2 / 32), I_DN = (FF / 64) * (DM / 32);
    constexpr int NITEMS = I_IN + I_RO + I_SO + I_OUT + I_UP + I_DN;
    unsigned char* ws = a.ws;
    for (int it = gw; it < NITEMS; it += NGW) {
        int r = it;
        if (r < I_IN) { p0_transpose_item<false>(a.w_in, DM, INW, (bf16*)(ws + WS_WIN), scr, r, lane); continue; } r -= I_IN;
        if (r < I_RO) { p0_transpose_item<false>(a.w_ret_o, DM, DM, (bf16*)(ws + WS_WRO), scr, r, lane, 3072, 0); continue; } r -= I_RO;
        if (r < I_SO) { p0_transpose_item<false>(a.w_swa_o, 1024, DM, (bf16*)(ws + WS_WRO), scr, r, lane, 3072, 2048);   continue; } r -= I_SO;
        if (r < I_OUT) { p0_transpose_item<false>(a.w_out, DM, DM, (bf16*)(ws + WS_WOUT), scr, r, lane); continue; } r -= I_OUT;
        if (r < I_UP) { p0_transpose_item<true>(a.w_up, DM, FF2, (bf16*)(ws + WS_WUP), scr, r, lane); continue; } r -= I_UP;
        p0_transpose_item<false>(a.w_down, FF, DM, (bf16*)(ws + WS_WDN), scr, r, lane);
    }
    for (int m = gw; m < MTOK; m += NGW) rms_row_to_bf16(a.x + (size_t)m * DM, a.g_pre_mix, (bf16*)(ws + WS_H) + (size_t)m * DM, lane);
    float* rc = (float*)(ws + WS_ROPE); float* rs = rc + SEQ * 64;
    for (int e = blockIdx.x * NTHR + tid; e < SEQ * 64; e += G * NTHR) {
        const int pos = e >> 6, i = e & 63;
        const float inv = 1.0f / powf(10000.0f, (float)(2 * i) / 128.0f);
        const float ang = (float)pos * inv;
        const double rev = (double)ang * 0.15915494309189533577; const float fr = (float)(rev - floor(rev));
        rc[e] = __builtin_amdgcn_cosf(fr); rs[e] = __builtin_amdgcn_sinf(fr);
    }
}

__device__ __forceinline__ void unpack8(const u32x4 w, float (&f)[8]) { f[0] = pg8::bf_lo(w.x); f[1] = pg8::bf_hi(w.x); f[2] = pg8::bf_lo(w.y); f[3] = pg8::bf_hi(w.y); f[4] = pg8::bf_lo(w.z); f[5] = pg8::bf_hi(w.z); f[6] = pg8::bf_lo(w.w); f[7] = pg8::bf_hi(w.w); }
typedef float f32x16 __attribute__((ext_vector_type(16)));
typedef short bf16x8v __attribute__((ext_vector_type(8)));
typedef float f32x2v __attribute__((ext_vector_type(2)));
typedef __bf16 bf16x2v __attribute__((ext_vector_type(2)));
#define MFMA32(a, b, c) __builtin_amdgcn_mfma_f32_32x32x16_bf16((a), (b), (c), 0, 0, 0)
__device__ __forceinline__ int crow(int i, int h) { return (i & 3) + 8 * (i >> 2) + 4 * h; }
__device__ __forceinline__ unsigned cvtpk(float lo, float hi) { f32x2v v = {lo, hi}; bf16x2v b = __builtin_convertvector(v, bf16x2v); return __builtin_bit_cast(unsigned, b); }
__device__ __forceinline__ bf16x8v pack_step(const f32x16& x, int s) {
    u32x4 p; p.x = cvtpk(x[8 * s], x[8 * s + 1]); p.y = cvtpk(x[8 * s + 2], x[8 * s + 3]); p.z = cvtpk(x[8 * s + 4], x[8 * s + 5]); p.w = cvtpk(x[8 * s + 6], x[8 * s + 7]);
    return __builtin_bit_cast(bf16x8v, p);
}
__device__ __forceinline__ void lds_barrier() { asm volatile("s_waitcnt lgkmcnt(0)\n\ts_barrier" ::: "memory"); }
constexpr int RET_RS = 272;
constexpr int RET_TILE = 128 * RET_RS;
typedef short s16x4v __attribute__((ext_vector_type(4)));
__device__ __forceinline__ s16x4v lds_tr(const LAS unsigned char* p) { return __builtin_bit_cast(s16x4v, __builtin_amdgcn_ds_read_tr16_b64_v4i16((LAS s16x4v*)p)); }
__device__ __forceinline__ bf16x8v cat8(s16x4v lo, s16x4v hi) { return __builtin_shufflevector(lo, hi, 0, 1, 2, 3, 4, 5, 6, 7); }
__device__ __forceinline__ void ret_mfma(LAS unsigned char* lds, bf16* proj, const float* rc, const float* rs, int b, int hd, const int swave) {
    LAS unsigned char* Qs = lds; LAS unsigned char* Ks = lds + RET_TILE; LAS unsigned char* Ps = lds + 2 * RET_TILE;
    LAS float* red = (LAS float*)(lds + 3 * RET_TILE);
    const int lane = lane_id_asm(), w = swave, tid = w * 64 + lane, r = lane & 31, h = lane >> 5;
    LAS unsigned char* vs = lds + 3 * RET_TILE + 4096 + w * 4096;
    const int i16 = lane & 15, q4 = i16 >> 2, p4 = i16 & 3, blk = (lane >> 4) & 1;
    const int troff = (8 * h + q4) * 64 + 32 * blk + 8 * p4;
    const int ktr = (8 * h + q4) * RET_RS + (16 * blk + 4 * p4) * 2;
    const float lg = log2f(1.0f - exp2f(-5.0f - (float)hd));
    f32x16 X[4];
#pragma unroll
    for (int t = 0; t < 4; ++t)
#pragma unroll
        for (int i = 0; i < 16; ++i) X[t][i] = 0.f;
    for (int n = 0; n < SEQ / 128; ++n) {
        const size_t row0 = (size_t)b * SEQ + (size_t)n * 128;
#pragma unroll 1
        for (int which = 0; which < 2; ++which) {
#pragma unroll
            for (int it = 0; it < 2; ++it) { const int task = tid + 512 * it, tok = task >> 3, d0 = (task & 7) * 8;
                const bf16* p = proj + (size_t)(which * 4 + (hd >> 1)) * PST + (row0 + tok) * 256 + (hd & 1) * 128;
                float x1[8], x2[8]; unpack8(__builtin_nontemporal_load((const u32x4*)(p + d0)), x1); unpack8(__builtin_nontemporal_load((const u32x4*)(p + d0 + 64)), x2);
                const float* cp = rc + (size_t)(n * 128 + tok) * 64 + d0; const float* sp = rs + (size_t)(n * 128 + tok) * 64 + d0;
                const f32x4 c0 = *(const f32x4*)cp, c1 = *(const f32x4*)(cp + 4), s0 = *(const f32x4*)sp, s1 = *(const f32x4*)(sp + 4);
                const float cs[8] = {c0.x, c0.y, c0.z, c0.w, c1.x, c1.y, c1.z, c1.w}, sn[8] = {s0.x, s0.y, s0.z, s0.w, s1.x, s1.y, s1.z, s1.w};
                const float sc = which ? 0.08838834764831845f * __builtin_amdgcn_exp2f(lg * (float)(127 - tok)) : 1.0f;
                float y1[8], y2[8];
#pragma unroll
                for (int e = 0; e < 8; ++e) { y1[e] = (x1[e] * cs[e] - x2[e] * sn[e]) * sc; y2[e] = (x1[e] * sn[e] + x2[e] * cs[e]) * sc; }
                LAS unsigned char* base = which ? Ks : Qs;
                u32x4 o1, o2; o1.x = cvtpk(y1[0], y1[1]); o1.y = cvtpk(y1[2], y1[3]); o1.z = cvtpk(y1[4], y1[5]); o1.w = cvtpk(y1[6], y1[7]);
                o2.x = cvtpk(y2[0], y2[1]); o2.y = cvtpk(y2[2], y2[3]); o2.z = cvtpk(y2[4], y2[5]); o2.w = cvtpk(y2[6], y2[7]);
                *(LAS u32x4*)(base + tok * RET_RS + d0 * 2) = o1; *(LAS u32x4*)(base + tok * RET_RS + (d0 + 64) * 2) = o2; } }
        u32x4 vraw[8];
        { int l2 = lane; asm volatile("" : "+v"(l2));
          const bf16* vp = proj + (size_t)(PN_RV + hd) * PST + (row0 + 16 * 0) * 256 + 32 * w + (unsigned)((l2 >> 2) * 256 + 8 * (l2 & 3));
#pragma unroll
          for (int s = 0; s < 8; ++s) vraw[s] = __builtin_nontemporal_load((const u32x4*)(vp + (16 * s) * 256)); }
        lds_barrier();
        for (int bi = w; bi < 10; bi += 8) { const int qb = bi < 1 ? 0 : (bi < 3 ? 1 : (bi < 6 ? 2 : 3)), kb = bi - (qb * (qb + 1)) / 2;
            f32x16 x;
#pragma unroll
            for (int i = 0; i < 16; ++i) x[i] = 0.f;
#pragma unroll
            for (int s = 0; s < 8; ++s) { const bf16x8v ka = *(const LAS bf16x8v*)(Ks + (32 * kb + r) * RET_RS + (16 * s + 8 * h) * 2); const bf16x8v qv = *(const LAS bf16x8v*)(Qs + (32 * qb + r) * RET_RS + (16 * s + 8 * h) * 2); x = MFMA32(ka, qv, x); }
            const float qsc = __builtin_amdgcn_exp2f(lg * (float)(32 * qb + r - 127));
#pragma unroll
            for (int g = 0; g < 4; ++g) { float pv[4];
#pragma unroll
                for (int e = 0; e < 4; ++e) { const int i = 4 * g + e; const int d = 32 * (qb - kb) + r - crow(i, h); pv[e] = d >= 0 ? x[i] * qsc : 0.f; }
                u32x2 pw; pw.x = cvtpk(pv[0], pv[1]); pw.y = cvtpk(pv[2], pv[3]);
                *(LAS u32x2*)(Ps + (32 * qb + r) * RET_RS + (32 * kb + 8 * g + 4 * h) * 2) = pw; } }
        bf16x8v Vf[8];
#pragma unroll
        for (int hf = 0; hf < 2; ++hf) {
#pragma unroll
            for (int s4 = 0; s4 < 4; ++s4) *(LAS u32x4*)(vs + s4 * 1024 + lane * 16) = vraw[4 * hf + s4];
            LDS_WAIT();
#pragma unroll
            for (int s4 = 0; s4 < 4; ++s4) Vf[4 * hf + s4] = cat8(lds_tr(vs + s4 * 1024 + troff), lds_tr(vs + s4 * 1024 + troff + 256));
            LDS_WAIT();
        }
        bf16x8v Sp[4][2];
#pragma unroll
        for (int t = 0; t < 4; ++t) { Sp[t][0] = pack_step(X[t], 0); Sp[t][1] = pack_step(X[t], 1); }
        u32x2 gwn[4];
#pragma unroll
        for (int g = 0; g < 4; ++g) gwn[g] = *(const u32x2*)(proj + (size_t)(PN_RG + hd) * PST + (row0 + r) * 256 + 32 * w + 8 * g + 4 * h);
        lds_barrier();
#pragma unroll
        for (int qb = 0; qb < 4; ++qb) {
            f32x16 zi, zc;
#pragma unroll
            for (int i = 0; i < 16; ++i) { zi[i] = 0.f; zc[i] = 0.f; }
            u32x2 gwc[4];
#pragma unroll
            for (int g = 0; g < 4; ++g) { gwc[g] = gwn[g]; if (qb < 3) gwn[g] = *(const u32x2*)(proj + (size_t)(PN_RG + hd) * PST + (row0 + 32 * (qb + 1) + r) * 256 + 32 * w + 8 * g + 4 * h); }
#pragma unroll
            for (int kb = 0; kb <= qb; ++kb)
#pragma unroll
                for (int s2 = 0; s2 < 2; ++s2) { const bf16x8v pq = *(const LAS bf16x8v*)(Ps + (32 * qb + r) * RET_RS + (32 * kb + 16 * s2 + 8 * h) * 2); zi = MFMA32(Vf[2 * kb + s2], pq, zi); }
#pragma unroll
            for (int t = 0; t < 4; ++t)
#pragma unroll
                for (int s2 = 0; s2 < 2; ++s2) { const LAS unsigned char* qp = Qs + (32 * qb + r) * RET_RS + (32 * t + 16 * s2 + 4 * h) * 2;
                    const u32x2 lo = *(const LAS u32x2*)qp, hi = *(const LAS u32x2*)(qp + 16); u32x4 qq; qq.x = lo.x; qq.y = lo.y; qq.z = hi.x; qq.w = hi.y;
                    zc = MFMA32(Sp[t][s2], __builtin_bit_cast(bf16x8v, qq), zc); }
            const float xi = __builtin_amdgcn_exp2f(lg * (float)(32 * qb + r + 1));
            float ssq = 0.f;
#pragma unroll
            for (int i = 0; i < 16; ++i) { zi[i] = zi[i] + xi * zc[i]; ssq += zi[i] * zi[i]; }
            ssq += __shfl_xor(ssq, 32);
            if (h == 0) red[(32 * qb + r) * 8 + w] = ssq;
            lds_barrier();
            const f32x4 ra = *(const LAS f32x4*)(red + (32 * qb + r) * 8), rb = *(const LAS f32x4*)(red + (32 * qb + r) * 8 + 4);
            const float rstd = rsqrtf(((ra.x + ra.y) + (ra.z + ra.w) + (rb.x + rb.y) + (rb.z + rb.w)) * (1.f / 256.f) + RMS_EPS);
#pragma unroll
            for (int g = 0; g < 4; ++g) { const u32x2 gw = gwc[g];
                u32x2* op = (u32x2*)(proj + (size_t)(PN_RG + hd) * PST + (row0 + 32 * qb + r) * 256 + 32 * w + 8 * g + 4 * h);
                const float g0 = pg8::bf_lo(gw.x), g1 = pg8::bf_hi(gw.x), g2 = pg8::bf_lo(gw.y), g3 = pg8::bf_hi(gw.y);
                u32x2 ow; ow.x = cvtpk(g0 * pg8::sigmoidf_(g0) * zi[4 * g] * rstd, g1 * pg8::sigmoidf_(g1) * zi[4 * g + 1] * rstd); ow.y = cvtpk(g2 * pg8::sigmoidf_(g2) * zi[4 * g + 2] * rstd, g3 * pg8::sigmoidf_(g3) * zi[4 * g + 3] * rstd);
                *op = ow; }
        }
        { const float dec = __builtin_amdgcn_exp2f(lg * 128.f);
#pragma unroll
          for (int t = 0; t < 4; ++t) {
#pragma unroll
              for (int i = 0; i < 16; ++i) X[t][i] *= dec;
#pragma unroll
              for (int s = 0; s < 8; ++s) { const LAS unsigned char* kp = Ks + ktr + (16 * s) * RET_RS + (32 * t) * 2; X[t] = MFMA32(cat8(lds_tr(kp), lds_tr(kp + 4 * RET_RS)), Vf[s], X[t]); } } }
        lds_barrier();
    }
}

constexpr int SW_RS = 144;
__device__ __forceinline__ void swa_mfma(LAS unsigned char* lds, bf16* proj, const float* sinks, int unit0, int ustride, const int swave) {
    const int lane = lane_id_asm(), w = swave, tid = w * 64 + lane, r = lane & 31, h = lane >> 5;
    const int i16 = lane & 15, q4 = i16 >> 2, p4 = i16 & 3, blk = (lane >> 4) & 1;
    LAS unsigned char* Kb = lds; LAS unsigned char* Vb = lds + 256 * SW_RS;
    const int g = w >> 1, qh = w & 1;
    const int vtr = (4 * h + q4) * SW_RS + (16 * blk + 4 * p4) * 2;
    for (int u = unit0; u < NB * 4 * (SEQ / 128); u += ustride) {
        const int n = u & 15, hk = (u >> 4) & 3, b = u >> 6;
        const size_t rowb = (size_t)b * SEQ + (size_t)n * 128;
#pragma unroll
        for (int it = 0; it < 4; ++it) { const int pi = tid + 512 * it, row = pi >> 3, c8 = pi & 7;
            u32x4 kv = {0u, 0u, 0u, 0u}, vv = {0u, 0u, 0u, 0u};
            if (n > 0 || row >= 128) { const bf16* p = proj + (size_t)PN_SK * PST + (rowb + row - 128) * 256 + hk * 64 + c8 * 8; kv = __builtin_nontemporal_load((const u32x4*)p); vv = __builtin_nontemporal_load((const u32x4*)(p + PST)); }
            *(LAS u32x4*)(Kb + row * SW_RS + c8 * 16) = kv; *(LAS u32x4*)(Vb + row * SW_RS + c8 * 16) = vv; }
        lds_barrier();
        const float sk = sinks[hk * 4 + g];
#pragma unroll 1
        for (int qg = 0; qg < 2; ++qg) { const int p0 = 64 * qh + 32 * qg, kb0 = 2 * qh + qg;
            bf16* qrow = proj + (size_t)(PN_SQ + hk) * PST + (rowb + p0 + r) * 256 + g * 64;
            bf16x8v qf[4];
#pragma unroll
            for (int s = 0; s < 4; ++s) qf[s] = __builtin_nontemporal_load((const bf16x8v*)(qrow + 16 * s + 8 * h));
            f32x16 x[5];
#pragma unroll
            for (int j = 0; j < 5; ++j) {
#pragma unroll
                for (int i = 0; i < 16; ++i) x[j][i] = 0.f;
#pragma unroll
                for (int s = 0; s < 4; ++s) { const bf16x8v ka = *(const LAS bf16x8v*)(Kb + (32 * (kb0 + j) + r) * SW_RS + (16 * s + 8 * h) * 2); x[j] = MFMA32(ka, qf[s], x[j]); } }
            float m = -INFINITY;
#pragma unroll
            for (int j = 0; j < 5; ++j) { const float boff = ((n > 0) || (kb0 + j >= 4)) ? 0.f : -INFINITY;
#pragma unroll
                for (int i = 0; i < 16; ++i) { float a = x[j][i] * 0.125f + boff;
                    if (j == 0) a = (crow(i, h) > r) ? a : -INFINITY;
                    if (j == 4) a = (crow(i, h) <= r) ? a : -INFINITY;
                    x[j][i] = a; m = fmaxf(m, a); } }
            m = fmaxf(m, __shfl_xor(m, 32)); m = fmaxf(m, sk);
            float sum = 0.f;
#pragma unroll
            for (int j = 0; j < 5; ++j)
#pragma unroll
                for (int i = 0; i < 16; ++i) { const float e = __expf(x[j][i] - m); x[j][i] = e; sum += e; }
            sum += __shfl_xor(sum, 32);
            const float inv = 1.0f / (sum + __expf(sk - m));
            f32x16 o[2];
#pragma unroll
            for (int i = 0; i < 16; ++i) { o[0][i] = 0.f; o[1][i] = 0.f; }
#pragma unroll
            for (int j = 0; j < 5; ++j)
#pragma unroll
                for (int s = 0; s < 2; ++s) { const bf16x8v pb = pack_step(x[j], s);
#pragma unroll
                    for (int db = 0; db < 2; ++db) { const LAS unsigned char* vp = Vb + vtr + (32 * (kb0 + j) + 16 * s) * SW_RS + (32 * db) * 2;
                        o[db] = MFMA32(cat8(lds_tr(vp), lds_tr(vp + 8 * SW_RS)), pb, o[db]); } }
#pragma unroll
            for (int db = 0; db < 2; ++db)
#pragma unroll
                for (int gq = 0; gq < 4; ++gq) { u32x2 wv; wv.x = cvtpk(o[db][4 * gq] * inv, o[db][4 * gq + 1] * inv); wv.y = cvtpk(o[db][4 * gq + 2] * inv, o[db][4 * gq + 3] * inv);
                    *(u32x2*)(qrow + 32 * db + 8 * gq + 4 * h) = wv; }
        }
        lds_barrier();
    }
}

__device__ __forceinline__ void p4n_rows(const Args& a, int G, const int swave) {
    const int lane = lane_id_asm(), wave = swave; const int gw = blockIdx.x * NWAVES + wave, NGW = G * NWAVES;
    bf16* H = (bf16*)(a.ws + WS_H); float* rstd1 = (float*)(a.ws + WS_RSTD1);
    for (int m0 = gw; m0 < MTOK; m0 += 2 * NGW) {
        f32x4 v[2][8], xv[2][8];
#pragma unroll
        for (int rr = 0; rr < 2; ++rr) { const int m = (m0 + rr * NGW < MTOK) ? m0 + rr * NGW : m0;
            const u32x2* yb = (const u32x2*)((const bf16*)(a.ws + WS_Y1) + (size_t)m * 256) + lane; const f32x4* xr = (const f32x4*)(a.x + (size_t)m * DM) + lane;
#pragma unroll
            for (int j = 0; j < 8; ++j) { const u32x2 yw = __builtin_nontemporal_load(yb + (PST / 4) * j); v[rr][j] = (f32x4){pg8::bf_lo(yw.x), pg8::bf_hi(yw.x), pg8::bf_lo(yw.y), pg8::bf_hi(yw.y)}; xv[rr][j] = __builtin_nontemporal_load(xr + 64 * j); } }
#pragma unroll
        for (int rr = 0; rr < 2; ++rr) { const int m = m0 + rr * NGW; if (m >= MTOK) break;
            float s = 0.f;
#pragma unroll
            for (int j = 0; j < 8; ++j) s += (v[rr][j].x * v[rr][j].x + v[rr][j].y * v[rr][j].y) + (v[rr][j].z * v[rr][j].z + v[rr][j].w * v[rr][j].w);
            const float rstd = rsqrtf(wave_sum(s) * (1.f / DM) + RMS_EPS); float s2 = 0.f;
            if (lane == 0) rstd1[m] = rstd;
#pragma unroll
            for (int j = 0; j < 8; ++j) { const f32x4 gv = ((const f32x4*)a.g_post_mix)[lane + 64 * j]; const f32x4 t = xv[rr][j] + v[rr][j] * rstd * gv; v[rr][j] = t;
                s2 += (t.x * t.x + t.y * t.y) + (t.z * t.z + t.w * t.w); }
            const float rstd2 = rsqrtf(wave_sum(s2) * (1.f / DM) + RMS_EPS);
            u32x2* o8 = (u32x2*)(H + (size_t)m * DM) + lane;
#pragma unroll
            for (int j = 0; j < 8; ++j) { const f32x4 gv = ((const f32x4*)a.g_pre_ffn)[lane + 64 * j]; const f32x4 t = v[rr][j]; u32x2 w; w.x = pk2(t.x * rstd2 * gv.x, t.y * rstd2 * gv.y); w.y = pk2(t.z * rstd2 * gv.z, t.w * rstd2 * gv.w); o8[64 * j] = w; } }
    }
}
__device__ __forceinline__ void p6n_rows(const Args& a, int G, const int swave) {
    const int lane = lane_id_asm(), wave = swave; const int gw = blockIdx.x * NWAVES + wave, NGW = G * NWAVES;
    const bf16* Y2 = (const bf16*)(a.ws + WS_Y2); const bf16* Y1 = (const bf16*)(a.ws + WS_Y1); const float* rstd1 = (const float*)(a.ws + WS_RSTD1);
    for (int m = gw; m < MTOK; m += NGW) {
        f32x4 v[8], y1v[8], xv[8];
        const u32x2* yb = (const u32x2*)(Y2 + (size_t)m * 256) + lane; const u32x2* y1b = (const u32x2*)(Y1 + (size_t)m * 256) + lane; const f32x4* xr = (const f32x4*)(a.x + (size_t)m * DM) + lane;
        const float r1 = rstd1[m];
#pragma unroll
        for (int j = 0; j < 8; ++j) { const u32x2 yw = __builtin_nontemporal_load(yb + (PST / 4) * j), zw = __builtin_nontemporal_load(y1b + (PST / 4) * j);
            v[j] = (f32x4){pg8::bf_lo(yw.x), pg8::bf_hi(yw.x), pg8::bf_lo(yw.y), pg8::bf_hi(yw.y)}; y1v[j] = (f32x4){pg8::bf_lo(zw.x), pg8::bf_hi(zw.x), pg8::bf_lo(zw.y), pg8::bf_hi(zw.y)}; xv[j] = __builtin_nontemporal_load(xr + 64 * j); }
        f32x4* orow = (f32x4*)(a.out + (size_t)m * DM) + lane; float s = 0.f;
#pragma unroll
        for (int j = 0; j < 8; ++j) s += (v[j].x * v[j].x + v[j].y * v[j].y) + (v[j].z * v[j].z + v[j].w * v[j].w);
        const float rstd = rsqrtf(wave_sum(s) * (1.f / DM) + RMS_EPS);
#pragma unroll
        for (int j = 0; j < 8; ++j) { const f32x4 g1 = ((const f32x4*)a.g_post_mix)[lane + 64 * j], g2 = ((const f32x4*)a.g_post_ffn)[lane + 64 * j];
            const f32x4 x1 = xv[j] + y1v[j] * r1 * g1; __builtin_nontemporal_store(x1 + v[j] * rstd * g2, orow + 64 * j); }
    }
}
__device__ __forceinline__ void p5f_fixup(const Args& a, int G, const int swave) {
    const int tid = swave * 64 + lane_id_asm();
    bf16* Gp = (bf16*)(a.ws + WS_PROJ); const bf16* edge = (const bf16*)(a.ws + WS_EDGE);
    constexpr int NT = (MTOK / 64) * 44 * 16;
    for (int task = blockIdx.x * NTHR + tid; task < NT; task += G * NTHR) {
        const int pc = task & 15, pn = (task >> 4) % 44, Gi = task / (16 * 44); const int ct = pc * 8, C = pn * 128 + ct;
        float wv[3][8], wg[3][8], bv[8], bg[8];
#pragma unroll
        for (int k = 0; k < 3; ++k)
#pragma unroll
            for (int e = 0; e < 8; ++e) { wv[k][e] = a.conv_w[k * FF2 + C + e]; wg[k][e] = a.conv_w[k * FF2 + FF + C + e]; }
#pragma unroll
        for (int e = 0; e < 8; ++e) { bv[e] = a.conv_b[C + e]; bg[e] = a.conv_b[FF + C + e]; }
        float pv2[8], pv1[8], pg2[8], pg1[8], cv0[8], cg0[8], cv1[8], cg1[8];
        if ((Gi & 31) == 0) {
#pragma unroll
            for (int e = 0; e < 8; ++e) { pv2[e] = 0.f; pv1[e] = 0.f; pg2[e] = 0.f; pg1[e] = 0.f; }
        } else { const bf16* ep = edge + ((size_t)((Gi - 1) * 4 + 2) * 44 + pn) * 256 + ct;
            unpack8(*(const u32x4*)ep, pv2); unpack8(*(const u32x4*)(ep + 128), pg2); unpack8(*(const u32x4*)(ep + 44 * 256), pv1); unpack8(*(const u32x4*)(ep + 44 * 256 + 128), pg1); }
        { const bf16* ep = edge + ((size_t)(Gi * 4) * 44 + pn) * 256 + ct;
            unpack8(*(const u32x4*)ep, cv0); unpack8(*(const u32x4*)(ep + 128), cg0); unpack8(*(const u32x4*)(ep + 44 * 256), cv1); unpack8(*(const u32x4*)(ep + 44 * 256 + 128), cg1); }
        float o0[8], o1[8];
#pragma unroll
        for (int e = 0; e < 8; ++e) {
            const float yv0 = bv[e] + wv[0][e] * pv2[e] + wv[1][e] * pv1[e] + wv[2][e] * cv0[e], yg0 = bg[e] + wg[0][e] * pg2[e] + wg[1][e] * pg1[e] + wg[2][e] * cg0[e];
            const float yv1 = bv[e] + wv[0][e] * pv1[e] + wv[1][e] * cv0[e] + wv[2][e] * cv1[e], yg1 = bg[e] + wg[0][e] * pg1[e] + wg[1][e] * cg0[e] + wg[2][e] * cg1[e];
            o0[e] = pg8::gelu_tanh_f(yg0) * yv0; o1[e] = pg8::gelu_tanh_f(yg1) * yv1; }
        bf16* gp = Gp + (size_t)(pn >> 1) * PST + (size_t)(Gi * 64) * 256 + (pn & 1) * 128 + ct;
        u32x4 w; w.x = pk2(o0[0], o0[1]); w.y = pk2(o0[2], o0[3]); w.z = pk2(o0[4], o0[5]); w.w = pk2(o0[6], o0[7]); *(u32x4*)gp = w;
        w.x = pk2(o1[0], o1[1]); w.y = pk2(o1[2], o1[3]); w.z = pk2(o1[4], o1[5]); w.w = pk2(o1[6], o1[7]); *(u32x4*)(gp + 256) = w;
    }
}

#define XB_TMO      128
#define XB_XCNT(j)  (256  + 64 * (j))
#define XB_XSUB(j)  (1280 + 64 * (j))
#define XB_XGEN(j)  (2304 + 64 * (j))
#define XB_TOP      3328
#define XB_TOPGEN   3392
#define XCD_BAR_WORDS 3456
#define XB_SPIN_CAP (1u << 18)

__device__ __forceinline__ unsigned xb_ld(unsigned* p)              { return __hip_atomic_load(p, __ATOMIC_RELAXED, __HIP_MEMORY_SCOPE_AGENT); }
__device__ __forceinline__ unsigned xb_add(unsigned* p, unsigned v) { return __hip_atomic_fetch_add(p, v, __ATOMIC_RELAXED, __HIP_MEMORY_SCOPE_AGENT); }
__device__ __forceinline__ unsigned xb_xcc_id() { return (unsigned)__builtin_amdgcn_s_getreg((3 << 11) | 20) & 0xFu; }
#define XB_SPIN(cond, bar) do { unsigned _sp = 0; while (cond) { __builtin_amdgcn_s_sleep(1); \
    if ((++_sp & 255u) == 0u) { if (xb_ld(&(bar)[XB_TMO])) break; if (_sp > XB_SPIN_CAP) { atomicAdd(&(bar)[XB_TMO], 1u); break; } } } } while (0)

struct XcdBarrier {
    unsigned* bar; unsigned x;
    volatile LAS unsigned* st;
};

__device__ __forceinline__ XcdBarrier xcd_barrier_post(unsigned* bar, volatile LAS unsigned* st, const int swave) {
    XcdBarrier b; b.bar = bar; b.x = xb_xcc_id(); b.st = st;
    if (swave == 0 && lane_id_asm() == 0) (void)xb_add(&bar[XB_XCNT(b.x)], 1u);
    return b;
}
__device__ __forceinline__ void xcd_barrier_complete(unsigned* bar, unsigned x, unsigned& nloc, unsigned& nx) {
    const unsigned G = gridDim.x * gridDim.y * gridDim.z;
    unsigned sum, cnt, mine, sp = 0u;
    for (;;) {
        sum = 0u; cnt = 0u; mine = 0u;
#pragma unroll
        for (unsigned j = 0; j < 16; ++j) { const unsigned c = xb_ld(&bar[XB_XCNT(j)]); sum += c; cnt += (c > 0u) ? 1u : 0u; mine = (j == x) ? c : mine; }
        if (sum == G) break;
        __builtin_amdgcn_s_sleep(1);
        if ((++sp & 255u) == 0u) { if (xb_ld(&bar[XB_TMO])) break; if (sp > XB_SPIN_CAP) { atomicAdd(&bar[XB_TMO], 1u); break; } }
    }
    nloc = mine > 0u ? mine : 1u; nx = cnt > 0u ? cnt : 1u;
}

__device__ __forceinline__ void xcd_barrier(const XcdBarrier& b, const int swave) {
    asm volatile("s_waitcnt vmcnt(0)" ::: "memory");
    __syncthreads();
    if (swave == 0 && lane_id_asm() == 0) {
        unsigned* bar = b.bar;
        __builtin_amdgcn_s_waitcnt(0);
        unsigned nloc = b.st[0], nx = b.st[1];
        if (nloc == 0u) { xcd_barrier_complete(bar, b.x, nloc, nx); b.st[0] = nloc; b.st[1] = nx; }
        const unsigned old = xb_add(&bar[XB_XSUB(b.x)], 1u);
        const unsigned gen = old / nloc;
        if (old + 1u == (gen + 1u) * nloc) {
            __builtin_amdgcn_fence(__ATOMIC_RELEASE, "agent");
            asm volatile("s_waitcnt vmcnt(0)" ::: "memory");
            const unsigned og = xb_add(&bar[XB_TOP], 1u);
            const unsigned tg = og / nx;
            if (og + 1u == (tg + 1u) * nx) xb_add(&bar[XB_TOPGEN], 1u);
            else XB_SPIN(xb_ld(&bar[XB_TOPGEN]) == tg, bar);
            __builtin_amdgcn_fence(__ATOMIC_ACQUIRE, "agent");
            xb_add(&bar[XB_XGEN(b.x)], 1u);
            asm volatile("s_waitcnt vmcnt(0)" ::: "memory");
        } else {
            XB_SPIN(xb_ld(&bar[XB_XGEN(b.x)]) == gen, bar);
            __builtin_amdgcn_fence(__ATOMIC_ACQUIRE, "agent");
            asm volatile("s_waitcnt vmcnt(0)" ::: "memory");
        }
    }
    __syncthreads();
}

__global__ void __launch_bounds__(NTHR, 2) fwd_megakernel(Args a) {
    extern __shared__ __attribute__((aligned(16))) unsigned char lds_raw[];
    LAS unsigned char* lds = (LAS unsigned char*)lds_raw;
    cg::grid_group grid = cg::this_grid();
    const int G = gridDim.x;
    unsigned char* ws = a.ws;
    const int swave = __builtin_amdgcn_readfirstlane(threadIdx.x >> 6);
    volatile LAS unsigned* bst = (volatile LAS unsigned*)(lds + LDS_BYTES - 16);
    if (threadIdx.x < 4) bst[threadIdx.x] = 0u;
    __syncthreads();
    const XcdBarrier bar = xcd_barrier_post((unsigned*)(ws + WS_CTL), bst, swave);
    bf16* H = (bf16*)(ws + WS_H); bf16* PROJ = (bf16*)(ws + WS_PROJ);

    p0_prologue(a, lds, G, swave);
    if (a.ws == nullptr) grid.sync();
    xcd_barrier(bar, swave);
    { pg8::Gemm g{H, (const bf16*)(ws + WS_WIN), MTOK, INW, DM, DM, 512}; pg8::StaticOrder S; S.init(MTOK, INW, G, (int)blockIdx.x);
      pg8::EpiBf16<false> E{PROJ, 256, PST, nullptr, 0};
      pg8::gemm_phase<pg8::EpiBf16<false>, pg8::StaticOrder, true, true>(lds, g, S, E, swave); }
    xcd_barrier(bar, swave);
    { const float* rc = (const float*)(ws + WS_ROPE); const float* rs = rc + SEQ * 64;
      if (blockIdx.x < 128 || G < 256) for (int u = blockIdx.x; u < 128; u += G) ret_mfma(lds, PROJ, rc, rs, u >> 3, u & 7, swave);
      const int su0 = (G >= 256) ? (int)blockIdx.x - 128 : (int)blockIdx.x, sst = (G >= 256) ? G - 128 : G;
      if (su0 >= 0) swa_mfma(lds, PROJ, a.sinks, su0, sst, swave); }
    xcd_barrier(bar, swave);
    { pg8::Gemm g{PROJ + (size_t)PN_RG * PST, (const bf16*)(ws + WS_WRO), MTOK, DM, 3072, 256, PST * 2}; pg8::StaticOrder S; S.init(MTOK, DM, G, (int)blockIdx.x);
      pg8::EpiGateOut E{PROJ + (size_t)PN_GS * PST, H, PST};
      pg8::MidGate mid{32, PROJ + (size_t)PN_GR * PST, PROJ + (size_t)PN_GS * PST, PST};
      pg8::gemm_phase<pg8::EpiGateOut, pg8::StaticOrder, true, true, pg8::MidGate>(lds, g, S, E, swave, mid); }
    xcd_barrier(bar, swave);
    { pg8::Gemm g{H, (const bf16*)(ws + WS_WOUT), MTOK, DM, DM, 256, PST * 2}; pg8::StaticOrder S; S.init(MTOK, DM, G, (int)blockIdx.x);
      pg8::EpiBf16<false> E{(bf16*)(ws + WS_Y1), 256, PST, nullptr, 0};
      pg8::gemm_phase<pg8::EpiBf16<false>, pg8::StaticOrder, true, true>(lds, g, S, E, swave); }
    xcd_barrier(bar, swave);
    p4n_rows(a, G, swave);
    xcd_barrier(bar, swave);
    { pg8::Gemm g{H, (const bf16*)(ws + WS_WUP), MTOK, FF2, DM, DM, 512}; pg8::StaticOrder S; S.init(MTOK, FF2, G, (int)blockIdx.x);
      pg8::EpiConv E{PROJ, PST, a.conv_w, a.conv_b, (bf16*)(ws + WS_EDGE), FF};
      pg8::gemm_phase<pg8::EpiConv, pg8::StaticOrder, true, true>(lds, g, S, E, swave); }
    xcd_barrier(bar, swave);
    p5f_fixup(a, G, swave);
    xcd_barrier(bar, swave);
    { pg8::Gemm g{PROJ, (const bf16*)(ws + WS_WDN), MTOK, DM, FF, 256, PST * 2}; pg8::StaticOrder S; S.init(MTOK, DM, G, (int)blockIdx.x);
      pg8::EpiBf16<false> E{(bf16*)(ws + WS_Y2), 256, PST, nullptr, 0};
      pg8::gemm_phase<pg8::EpiBf16<false>, pg8::StaticOrder, true, true>(lds, g, S, E, swave); }
    xcd_barrier(bar, swave);
    p6n_rows(a, G, swave);
}

extern "C" void kernel_launch(void* const* d_in, const int* in_sizes, int n_in, void* d_out, int out_size, void* d_ws, size_t ws_size, hipStream_t stream) {
    static int grid = 0;
    if (grid == 0) {
        if (n_in != 14 || ws_size < WS_END) { fprintf(stderr, "kernel_launch: unexpected n_in %d / ws_size %zu (need %zu)\n", n_in, ws_size, (size_t)WS_END); grid = -1; return; }
        int dev = 0, cus = 0, per_cu = 0;
        hipGetDevice(&dev); hipDeviceGetAttribute(&cus, hipDeviceAttributeMultiprocessorCount, dev);
        if (hipFuncSetAttribute((const void*)fwd_megakernel, hipFuncAttributeMaxDynamicSharedMemorySize, LDS_BYTES) != hipSuccess) { fprintf(stderr, "kernel_launch: hipFuncSetAttribute failed\n"); grid = -1; return; }
        if (hipOccupancyMaxActiveBlocksPerMultiprocessor(&per_cu, (const void*)fwd_megakernel, NTHR, LDS_BYTES) != hipSuccess || per_cu < 1) { fprintf(stderr, "kernel_launch: occupancy query says %d\n", per_cu); per_cu = 1; }
        (void)hipGetLastError();
        grid = cus * per_cu;
        fprintf(stderr, "kernel_launch: grid %d (cus %d x %d)\n", grid, cus, per_cu);
    }
    if (grid < 0) return;
    if (hipMemsetAsync((char*)d_ws + WS_CTL, 0, WS_CTL_BYTES, stream) != hipSuccess) { fprintf(stderr, "kernel_launch: memset failed\n"); return; }
    Args a{};
    a.x = (const float*)d_in[0]; a.g_pre_mix = (const float*)d_in[1]; a.w_in = (const float*)d_in[2]; a.w_ret_o = (const float*)d_in[3]; a.w_swa_o = (const float*)d_in[4];
    a.w_out = (const float*)d_in[5]; a.sinks = (const float*)d_in[6]; a.g_post_mix = (const float*)d_in[7]; a.g_pre_ffn = (const float*)d_in[8]; a.w_up = (const float*)d_in[9];
    a.conv_w = (const float*)d_in[10]; a.conv_b = (const float*)d_in[11]; a.w_down = (const float*)d_in[12]; a.g_post_ffn = (const float*)d_in[13];
    a.out = (float*)d_out; a.ws = (unsigned char*)d_ws;
    void* args[] = {&a};
    hipError_t e = hipLaunchCooperativeKernel((const void*)fwd_megakernel, dim3(grid), dim3(NTHR), args, LDS_BYTES, stream);
    if (e != hipSuccess) fprintf(stderr, "cooperative launch failed: %s (grid %d)\n", hipGetErrorString(e), grid);
}
```
